# Optimizing an MI355X kernel written in HIP

```python
import math
import jax, jax.numpy as jnp
from jax import lax
import numpy as np

D_MODEL = 1024
BATCH = 8
SEQ = 2048
DEPTH = 2

CONV_WIDTH = D_MODEL // 2
CONV_GROUPS = 8
CONV_K = 3
N_HEADS = 8
HEAD_DIM = 64
ATTN_WIDTH = N_HEADS * HEAD_DIM
D_FF = 2816
Q_BLOCK = 128
RMS_EPS = 1e-6
N_BRANCH = 2
IN_COLS = 3 * CONV_WIDTH + 3 * ATTN_WIDTH + N_BRANCH * D_MODEL

kernel_name = "hybrid_shortconv_stickbreaking_macaron"


def rmsnorm(x, g):
    xf = x.astype(jnp.float32)
    y = xf * lax.rsqrt(jnp.mean(xf * xf, axis=-1, keepdims=True) + RMS_EPS)
    return (y * g.astype(jnp.float32)).astype(x.dtype)


def swiglu(h, w13, w2):
    gu = h @ w13
    a, b = jnp.split(gu, 2, axis=-1)
    return (jax.nn.silu(a) * b) @ w2


def causal_depthwise_conv(u, w):
    c = u.shape[-1]
    return lax.conv_general_dilated(
        u, w[:, None, :].astype(u.dtype), window_strides=(1,), padding=[(CONV_K - 1, 0)],
        dimension_numbers=("NWC", "WIO", "NWC"), feature_group_count=c)


def stick_breaking_attention(q, k, v):
    b, s, h, dh = q.shape
    q = jnp.transpose(q, (0, 2, 1, 3))
    k = jnp.transpose(k, (0, 2, 1, 3))
    v = jnp.transpose(v, (0, 2, 1, 3))
    scale = 1.0 / math.sqrt(dh)
    outs = []
    for i in range(s // Q_BLOCK):
        q0 = i * Q_BLOCK
        end = q0 + Q_BLOCK
        qb = q[:, :, q0:end]
        kb = k[:, :, :end]
        vb = v[:, :, :end]
        z = jnp.einsum("bhqd,bhkd->bhqk", qb, kb).astype(jnp.float32) * scale
        t_pos = q0 + jnp.arange(Q_BLOCK)[:, None]
        s_pos = jnp.arange(end)[None, :]
        causal = s_pos < t_pos
        log_keep = jnp.where(causal, jax.nn.log_sigmoid(-z), 0.0)
        shifted = jnp.concatenate([log_keep[..., 1:], jnp.zeros_like(log_keep[..., :1])], axis=-1)
        excl = lax.cumsum(shifted, axis=shifted.ndim - 1, reverse=True)
        log_a = jax.nn.log_sigmoid(z) + excl
        a = jnp.where(causal, jnp.exp(log_a), 0.0)
        outs.append(jnp.einsum("bhqk,bhkd->bhqd", a.astype(vb.dtype), vb))
    o = jnp.concatenate(outs, axis=2)
    return jnp.transpose(o, (0, 2, 1, 3)).reshape(b, s, h * dh)


def setup_inputs(seed: int = 0) -> dict:
    key = jax.random.key(seed)
    ks = jax.random.split(key, 16)
    f32 = jnp.float32

    def w(k, shape, fan_in):
        return jax.random.normal(k, shape, f32) * (fan_in ** -0.5)

    def gain(k, shape):
        return 1.0 + 0.02 * jax.random.normal(k, shape, f32)

    return {
        "x": jax.random.normal(ks[0], (BATCH, SEQ, D_MODEL), f32),
        "ffn1_norm": gain(ks[1], (DEPTH, D_MODEL)),
        "ffn1_w13": w(ks[2], (DEPTH, D_MODEL, 2 * D_FF), D_MODEL),
        "ffn1_w2": w(ks[3], (DEPTH, D_FF, D_MODEL), D_FF),
        "mix_norm": gain(ks[4], (DEPTH, D_MODEL)),
        "w_in": w(ks[5], (DEPTH, D_MODEL, IN_COLS), D_MODEL),
        "b_gate": 0.01 * jax.random.normal(ks[6], (DEPTH, N_BRANCH * D_MODEL), f32),
        "conv_w": w(ks[7], (DEPTH, CONV_K, CONV_WIDTH), CONV_K),
        "w_conv_o": w(ks[8], (DEPTH, CONV_WIDTH, D_MODEL), CONV_WIDTH),
        "w_attn_o": w(ks[9], (DEPTH, ATTN_WIDTH, D_MODEL), ATTN_WIDTH),
        "w_out": w(ks[10], (DEPTH, D_MODEL, D_MODEL), D_MODEL),
        "ffn2_norm": gain(ks[11], (DEPTH, D_MODEL)),
        "ffn2_w13": w(ks[12], (DEPTH, D_MODEL, 2 * D_FF), D_MODEL),
        "ffn2_w2": w(ks[13], (DEPTH, D_FF, D_MODEL), D_FF),
        "final_norm": gain(ks[14], (D_MODEL,)),
    }


def reference(x, ffn1_norm, ffn1_w13, ffn1_w2, mix_norm, w_in, b_gate, conv_w,
              w_conv_o, w_attn_o, w_out, ffn2_norm, ffn2_w13, ffn2_w2, final_norm):
    b, s, _ = x.shape
    splits = [CONV_WIDTH, 2 * CONV_WIDTH, 3 * CONV_WIDTH,
              3 * CONV_WIDTH + ATTN_WIDTH, 3 * CONV_WIDTH + 2 * ATTN_WIDTH,
              3 * CONV_WIDTH + 3 * ATTN_WIDTH]
    for l in range(DEPTH):
        x = x + 0.5 * swiglu(rmsnorm(x, ffn1_norm[l]), ffn1_w13[l], ffn1_w2[l])

        h = rmsnorm(x, mix_norm[l])
        proj = h @ w_in[l]
        cb, cc, cx, q, k, v, gl = jnp.split(proj, splits, axis=-1)
        gates = jax.nn.sigmoid(gl + b_gate[l])
        g_conv, g_attn = jnp.split(gates, 2, axis=-1)

        conv_y = cb * causal_depthwise_conv(cc * cx, conv_w[l])
        conv_branch = conv_y @ w_conv_o[l]

        attn_y = stick_breaking_attention(q.reshape(b, s, N_HEADS, HEAD_DIM),
                                          k.reshape(b, s, N_HEADS, HEAD_DIM),
                                          v.reshape(b, s, N_HEADS, HEAD_DIM))
        attn_branch = attn_y @ w_attn_o[l]

        merged = g_conv * conv_branch + g_attn * attn_branch
        x = x + merged @ w_out[l]

        x = x + 0.5 * swiglu(rmsnorm(x, ffn2_norm[l]), ffn2_w13[l], ffn2_w2[l])
    return rmsnorm(x, final_norm)
```

```cpp
#include <hip/hip_runtime.h>
#include <hip/hip_cooperative_groups.h>
#include <cstdio>
#include <cstdint>
namespace cg = cooperative_groups;
__device__ __forceinline__ int ltid() { int t = threadIdx.x; asm volatile("" : "+v"(t)); return t; }
namespace pg8 {
#define PG8_LAS __attribute__((address_space(3)))
typedef unsigned short bf16_t;
typedef short bf16x8 __attribute__((ext_vector_type(8)));
typedef float f32x4 __attribute__((ext_vector_type(4)));
typedef unsigned u32x4 __attribute__((ext_vector_type(4)));
constexpr int BM = 256, BK = 64, HALF = 128, HTB = HALF * BK * 2  , STAGE_BYTES = 8 * HTB, NXCD = 8, WGM = 8;

__host__ __device__ __forceinline__ int lds_byte(int r, int c) { const int st = (r >> 4) * 2 + (c >> 5), rr = r & 15, cc = c & 31, ob = rr * 64 + cc * 2; return st * 1024 + (ob ^ (((ob >> 9) & 1) << 5)); }
__host__ __device__ __forceinline__ void stage_rc(int b, int& R, int& C) { const int st = b / 1024, sb = b % 1024, swz = sb ^ (((sb >> 9) & 1) << 5); R = (st >> 1) * 16 + swz / 64; C = (st & 1) * 32 + (swz % 64) / 2; }
__host__ __device__ __forceinline__ int perm32(int rho) { const int n = rho >> 4, i = rho & 15; return 8 * (i >> 2) + 4 * n + (i & 3); }

struct Unit { int pm, pn; };
struct Gemm { const bf16_t* A; const bf16_t* Bt; int M, N, K; };

struct StaticOrder {
    int nM, nN, nwg, G, c;
    __host__ __device__ void init(int M, int N, int G_, int c_) { nM = M / BM; nN = N / BM; nwg = nM * nN; G = G_; c = c_; }
    __host__ __device__ bool next(int i, Unit& u) const {
        const long L = (long)i * G + c; if (L >= nwg) return false;
        int wgid = (int)L; { const int q = nwg / NXCD, r = nwg % NXCD, xcd = wgid % NXCD, off = wgid / NXCD; wgid = (xcd < r ? xcd * (q + 1) : r * (q + 1) + (xcd - r) * q) + off; }
        const int nig = WGM * nN, gid = wgid / nig, fm = gid * WGM, gsz = (nM - fm) < WGM ? (nM - fm) : WGM;
        u.pm = fm + ((wgid % nig) % gsz); u.pn = (wgid % nig) / gsz; return true;
    }
    __device__ __forceinline__ void a_ready(const Unit&) const {}
    __device__ __forceinline__ void done(const Unit&) const {}
};

__device__ __forceinline__ unsigned cvt_pk_bf16(float lo, float hi) { unsigned r; asm volatile("v_cvt_pk_bf16_f32 %0, %1, %2" : "=v"(r) : "v"(lo), "v"(hi)); return r; }
typedef float f32x2 __attribute__((ext_vector_type(2)));

typedef unsigned u32x4e __attribute__((ext_vector_type(4)));
constexpr float LOG2E = 1.4426950408889634f;
constexpr float QSCALE = 0.125f * LOG2E;
__device__ __forceinline__ float rowscale(const float* ssq, int row) {
    const f32x4* p = (const f32x4*)(ssq + (size_t)row * 16);
    const f32x4 s = (p[0] + p[1]) + (p[2] + p[3]);
    return __builtin_amdgcn_rsqf(((s[0] + s[1]) + (s[2] + s[3])) * (1.0f / 1024.0f) + 1e-6f);
}
__device__ __forceinline__ float sigmoid_f(float x) { return __builtin_amdgcn_rcpf(1.0f + __builtin_amdgcn_exp2f(-x * LOG2E)); }
__device__ __forceinline__ u32x4e pack8(const f32x4 a, const f32x4 b) { u32x4e w; w.x = cvt_pk_bf16(a[0], a[1]); w.y = cvt_pk_bf16(a[2], a[3]); w.z = cvt_pk_bf16(b[0], b[1]); w.w = cvt_pk_bf16(b[2], b[3]); return w; }
__device__ __forceinline__ void unpack8(const u32x4e w, f32x4& a, f32x4& b) {
    a[0] = __uint_as_float(w.x << 16); a[1] = __uint_as_float(w.x & 0xffff0000u); a[2] = __uint_as_float(w.y << 16); a[3] = __uint_as_float(w.y & 0xffff0000u);
    b[0] = __uint_as_float(w.z << 16); b[1] = __uint_as_float(w.z & 0xffff0000u); b[2] = __uint_as_float(w.w << 16); b[3] = __uint_as_float(w.w & 0xffff0000u);
}
constexpr size_t EMiB = 1u << 20;
constexpr size_t EWS_SSQ = 1 * EMiB, EWS_XB = 49 * EMiB, EWS_ACT = 81 * EMiB, EWS_CB = 81 * EMiB, EWS_U = 97 * EMiB, EWS_Q = 113 * EMiB, EWS_K = 129 * EMiB, EWS_V = 145 * EMiB, EWS_G = 161 * EMiB, EWS_MG = 129 * EMiB;
enum { EP_SWIGLU = 0, EP_RESID = 1, EP_WIN = 2, EP_MERGE1 = 3, EP_MERGE2 = 4 };
struct EpiAll {
    static constexpr bool PERM = true, AFTER_DRAIN = false;
    int mode; float alpha;
    unsigned char* ws;
    float* outf;
    const float* base;
    const float* bgate;
    __device__ __forceinline__ void operator()(const f32x4 (&acc)[2][2][4][2], const Unit& u, int wr, int wc, int fr, int fq) const {
        const int row0 = u.pm * BM + wr * 64 + fr, lc = wc * 32 + 8 * fq, pn = u.pn;
        const float* ssq = (const float*)(ws + EWS_SSQ); float* ssq_out = (float*)(ws + EWS_SSQ);
        bf16_t* act = (bf16_t*)(ws + EWS_ACT); bf16_t* xb = (bf16_t*)(ws + EWS_XB);
        bf16_t* cb = (bf16_t*)(ws + EWS_CB); bf16_t* uu = (bf16_t*)(ws + EWS_U); bf16_t* q = (bf16_t*)(ws + EWS_Q); bf16_t* k = (bf16_t*)(ws + EWS_K); bf16_t* v = (bf16_t*)(ws + EWS_V);
        bf16_t* g = (bf16_t*)(ws + EWS_G); bf16_t* mg = (bf16_t*)(ws + EWS_MG);
        if (mode == EP_SWIGLU) {
#pragma unroll
            for (int ai = 0; ai < 2; ++ai)
#pragma unroll
                for (int m = 0; m < 4; ++m) { const int row = row0 + ai * HALF + m * 16; const float rs = rowscale(ssq, row);
                    f32x4 o[2];
#pragma unroll
                    for (int n = 0; n < 2; ++n) { const f32x4 a = acc[ai][0][m][n] * rs, b = acc[ai][1][m][n] * rs;
#pragma unroll
                        for (int e = 0; e < 4; ++e) o[n][e] = a[e] * sigmoid_f(a[e]) * b[e]; }
                    *(u32x4e*)(act + (size_t)row * 2816 + pn * 128 + lc) = pack8(o[0], o[1]); }
        } else if (mode == EP_RESID) {
#pragma unroll
            for (int ai = 0; ai < 2; ++ai)
#pragma unroll
                for (int m = 0; m < 4; ++m) { const int row = row0 + ai * HALF + m * 16; float s = 0.f;
#pragma unroll
                    for (int bj = 0; bj < 2; ++bj) { const size_t off = (size_t)row * 1024 + pn * BM + bj * HALF + lc;
                        const f32x4 x0 = *(const f32x4*)(base + off), x1 = *(const f32x4*)(base + off + 4);
                        const f32x4 y0 = x0 + acc[ai][bj][m][0] * alpha, y1 = x1 + acc[ai][bj][m][1] * alpha;
                        *(f32x4*)(outf + off) = y0; *(f32x4*)(outf + off + 4) = y1; *(u32x4e*)(xb + off) = pack8(y0, y1);
                        s += (y0[0] * y0[0] + y0[1] * y0[1]) + (y0[2] * y0[2] + y0[3] * y0[3]) + (y1[0] * y1[0] + y1[1] * y1[1]) + (y1[2] * y1[2] + y1[3] * y1[3]); }
                    s += __shfl_xor(s, 16); s += __shfl_xor(s, 32);
                    if (fq == 0) ssq_out[(size_t)row * 16 + pn * 4 + wc] = s; }
        } else if (mode == EP_WIN) {
#pragma unroll
            for (int ai = 0; ai < 2; ++ai)
#pragma unroll
                for (int m = 0; m < 4; ++m) { const int row = row0 + ai * HALF + m * 16; const float rs = rowscale(ssq, row);
                    if (pn >= 2 && pn < 6) {
                        const float rs2 = rs * rs;
                        const f32x4 o0 = acc[ai][0][m][0] * acc[ai][1][m][0] * rs2, o1 = acc[ai][0][m][1] * acc[ai][1][m][1] * rs2;
                        *(u32x4e*)(uu + (size_t)row * 512 + (pn - 2) * 128 + lc) = pack8(o0, o1);
                    } else {
#pragma unroll
                        for (int bj = 0; bj < 2; ++bj) { const int col = bj * HALF + lc;
                            if (pn < 2) { *(u32x4e*)(cb + (size_t)row * 512 + pn * BM + col) = pack8(acc[ai][bj][m][0] * rs, acc[ai][bj][m][1] * rs); }
                            else if (pn < 12) { const int t = (pn - 6) >> 1; bf16_t* dst = t == 0 ? q : (t == 1 ? k : v); const float sc = t == 0 ? rs * QSCALE : rs;
                                *(u32x4e*)(dst + (size_t)row * 512 + ((pn - 6) & 1) * BM + col) = pack8(acc[ai][bj][m][0] * sc, acc[ai][bj][m][1] * sc); }
                            else { const int gc = (pn - 12) * BM + col; const f32x4 b0 = *(const f32x4*)(bgate + gc), b1 = *(const f32x4*)(bgate + gc + 4);
                                const f32x4 z0 = acc[ai][bj][m][0] * rs + b0, z1 = acc[ai][bj][m][1] * rs + b1; f32x4 o0, o1;
#pragma unroll
                                for (int e = 0; e < 4; ++e) { o0[e] = sigmoid_f(z0[e]); o1[e] = sigmoid_f(z1[e]); }
                                *(u32x4e*)(g + (size_t)row * 2048 + gc) = pack8(o0, o1); } }
                    } }
        } else {
#pragma unroll
            for (int ai = 0; ai < 2; ++ai)
#pragma unroll
                for (int m = 0; m < 4; ++m) { const int row = row0 + ai * HALF + m * 16;
#pragma unroll
                    for (int bj = 0; bj < 2; ++bj) { const int col = pn * BM + bj * HALF + lc; bf16_t* ga = g + (size_t)row * 2048 + 1024 + col;
                        if (mode == EP_MERGE1) { f32x4 g0, g1; unpack8(*(const u32x4e*)ga, g0, g1); *(u32x4e*)ga = pack8(g0 * acc[ai][bj][m][0], g1 * acc[ai][bj][m][1]); }
                        else { f32x4 g0, g1, m0, m1; unpack8(*(const u32x4e*)(g + (size_t)row * 2048 + col), g0, g1); unpack8(*(const u32x4e*)ga, m0, m1);
                            *(u32x4e*)(mg + (size_t)row * 1024 + col) = pack8(m0 + g0 * acc[ai][bj][m][0], m1 + g1 * acc[ai][bj][m][1]); } } }
        }
    }
};
template <class Epi, class Sched, bool ALIGN_EPI = false, bool SP2 = false>
__device__ __forceinline__ void gemm_phase(PG8_LAS unsigned char* lds, const Gemm g, const Sched& S, const Epi& E) {
    const int tid = ltid(), wid = __builtin_amdgcn_readfirstlane(tid >> 6), lane = tid & 63, wr = wid >> 2, wc = wid & 3, fr = lane & 15, fq = lane >> 4;
    const int K = g.K, nt = K / BK;
    unsigned voffA[2], voffB[2];
#pragma unroll
    for (int i = 0; i < 2; ++i) { int R, C; stage_rc(tid * 16 + i * 8192, R, C); const int Rb = Epi::PERM ? ((R & ~31) + perm32(R & 31)) : R;
        voffA[i] = (unsigned)(R * K + C) * 2u; voffB[i] = (unsigned)(Rb * K + C) * 2u; }
    const size_t kstep = (size_t)(BK * 2);
    const size_t hstep = (size_t)HALF * K * 2;
    const size_t tstep = 2 * hstep;
    const unsigned ldsw = (unsigned)wid * 1024u;
    const int aoff = lds_byte(wr * 64 + fr, fq * 8), boff = lds_byte(wc * 32 + fr, fq * 8);
#define PG8_SA(b, h) (((b) * 2 + (h)) * HTB)
#define PG8_SB(b, h) ((4 + (b) * 2 + (h)) * HTB)
#define PG8_STAGE(bufoff, gbase, voff) do { _Pragma("unroll") for (int _i = 0; _i < 2; ++_i) \
        __builtin_amdgcn_global_load_lds((const unsigned*)((const char*)(gbase) + (voff)[_i]), (PG8_LAS unsigned*)(lds + (bufoff) + ldsw + _i * 8192), 16, 0, 0); } while (0)
#define PG8_LDA(dst, b, h) do { _Pragma("unroll") for (int m = 0; m < 4; ++m) _Pragma("unroll") for (int k = 0; k < 2; ++k) dst[m][k] = *(const PG8_LAS bf16x8*)(lds + PG8_SA(b, h) + aoff + m * 2048 + k * 1024); } while (0)
#define PG8_LDB(dst, b, h) do { _Pragma("unroll") for (int n = 0; n < 2; ++n) _Pragma("unroll") for (int k = 0; k < 2; ++k) dst[n][k] = *(const PG8_LAS bf16x8*)(lds + PG8_SB(b, h) + boff + n * 2048 + k * 1024); } while (0)
#define PG8_MMA(ai, bj, At, Bt) do { __builtin_amdgcn_s_setprio(1); _Pragma("unroll") for (int m = 0; m < 4; ++m) _Pragma("unroll") for (int n = 0; n < 2; ++n) _Pragma("unroll") for (int k = 0; k < 2; ++k) \
        acc[ai][bj][m][n] = __builtin_amdgcn_mfma_f32_16x16x32_bf16(Bt[n][k], At[m][k], acc[ai][bj][m][n], 0, 0, 0); __builtin_amdgcn_s_setprio(0); } while (0)
#define PG8_WAIT_V(n) asm volatile("s_waitcnt vmcnt(" #n ")" ::: "memory")
#define PG8_WAIT_L(n) asm volatile("s_waitcnt lgkmcnt(" #n ")" ::: "memory")
#define PG8_BAR __builtin_amdgcn_s_barrier()
#define PG8_SCHED __builtin_amdgcn_sched_barrier(0)
    Unit cur, nxt; int ui = 0;
    if (!S.next(0, cur)) return;
    f32x4 acc[2][2][4][2];
#pragma unroll
    for (int a = 0; a < 2; ++a)
#pragma unroll
        for (int b = 0; b < 2; ++b)
#pragma unroll
            for (int m = 0; m < 4; ++m)
#pragma unroll
                for (int n = 0; n < 2; ++n) acc[a][b][m][n] = (f32x4){0.f, 0.f, 0.f, 0.f};
    bf16x8 At[4][2], B0[2][2], B1[2][2];
    const char* cA = (const char*)g.A + (size_t)cur.pm * tstep; const char* cB = (const char*)g.Bt + (size_t)cur.pn * tstep;
    S.a_ready(cur);
    if constexpr (SP2) {
        PG8_STAGE(PG8_SB(0, 0), cB, voffB); PG8_STAGE(PG8_SB(0, 1), cB + hstep, voffB); PG8_STAGE(PG8_SA(0, 0), cA, voffA); PG8_STAGE(PG8_SA(0, 1), cA + hstep, voffA);
        if (wr == 1) PG8_BAR;
        PG8_WAIT_V(2); PG8_BAR;
        PG8_STAGE(PG8_SB(1, 0), cB + kstep, voffB); PG8_STAGE(PG8_SA(1, 0), cA + kstep, voffA); PG8_STAGE(PG8_SB(1, 1), cB + hstep + kstep, voffB);
        PG8_WAIT_V(6); PG8_BAR;
    } else {
        PG8_STAGE(PG8_SB(0, 0), cB, voffB); PG8_STAGE(PG8_SA(0, 0), cA, voffA); PG8_STAGE(PG8_SB(0, 1), cB + hstep, voffB); PG8_STAGE(PG8_SA(0, 1), cA + hstep, voffA);
        if (wr == 1) PG8_BAR;
        PG8_WAIT_V(4); PG8_BAR;
        PG8_STAGE(PG8_SB(1, 0), cB + kstep, voffB); PG8_STAGE(PG8_SA(1, 0), cA + kstep, voffA); PG8_STAGE(PG8_SB(1, 1), cB + hstep + kstep, voffB);
        PG8_WAIT_V(6); PG8_BAR;
    }
    for (;;) {
        const bool has_next = S.next(ui + 1, nxt);
        const char* nA = has_next ? (const char*)g.A + (size_t)nxt.pm * tstep : cA; const char* nB = has_next ? (const char*)g.Bt + (size_t)nxt.pn * tstep : cB;
        for (int t = 0; t < nt; t += 2) {
            const bool last = (t == nt - 2);
            const char* a1 = cA + (size_t)(t + 1) * kstep;
            const char* a2 = last ? nA : cA + (size_t)(t + 2) * kstep; const char* b2 = last ? nB : cB + (size_t)(t + 2) * kstep;
            const char* a3 = a2 + kstep; const char* b3 = b2 + kstep;
            if (last && has_next) S.a_ready(nxt);
            if constexpr (SP2) {
            PG8_LDB(B0, 0, 0); PG8_LDB(B1, 0, 1); PG8_SCHED; PG8_LDA(At, 0, 0); PG8_STAGE(PG8_SA(1, 1), a1 + hstep, voffA);
            PG8_WAIT_V(8); PG8_WAIT_L(0); PG8_BAR; PG8_MMA(0, 0, At, B0); PG8_MMA(0, 1, At, B1); PG8_BAR; PG8_SCHED;
            PG8_LDA(At, 0, 1); PG8_STAGE(PG8_SB(0, 0), b2, voffB); PG8_STAGE(PG8_SB(0, 1), b2 + hstep, voffB); PG8_STAGE(PG8_SA(0, 0), a2, voffA);
            PG8_WAIT_V(8); PG8_WAIT_L(0); PG8_BAR; PG8_MMA(1, 0, At, B0); PG8_MMA(1, 1, At, B1); PG8_BAR; PG8_SCHED;
            PG8_LDB(B0, 1, 0); PG8_LDB(B1, 1, 1); PG8_SCHED; PG8_LDA(At, 1, 0); PG8_STAGE(PG8_SA(0, 1), a2 + hstep, voffA);
            PG8_WAIT_V(8); PG8_WAIT_L(0); PG8_BAR; PG8_MMA(0, 0, At, B0); PG8_MMA(0, 1, At, B1); PG8_BAR; PG8_SCHED;
            PG8_LDA(At, 1, 1); PG8_STAGE(PG8_SB(1, 0), b3, voffB); PG8_STAGE(PG8_SB(1, 1), b3 + hstep, voffB); PG8_STAGE(PG8_SA(1, 0), a3, voffA);
            PG8_WAIT_V(8); PG8_WAIT_L(0); PG8_BAR; PG8_MMA(1, 0, At, B0); PG8_MMA(1, 1, At, B1); PG8_BAR; PG8_SCHED;
            } else {
            PG8_LDB(B0, 0, 0); PG8_SCHED; PG8_LDA(At, 0, 0); PG8_STAGE(PG8_SA(1, 1), a1 + hstep, voffA);
            PG8_WAIT_L(8); PG8_BAR; PG8_WAIT_L(0); PG8_MMA(0, 0, At, B0); PG8_BAR; PG8_SCHED;
            PG8_LDB(B1, 0, 1); PG8_STAGE(PG8_SB(0, 0), b2, voffB);
            PG8_BAR; PG8_WAIT_L(0); PG8_MMA(0, 1, At, B1); PG8_BAR;
            PG8_LDA(At, 0, 1); PG8_STAGE(PG8_SA(0, 0), a2, voffA);
            PG8_BAR; PG8_WAIT_L(0); PG8_MMA(1, 0, At, B0); PG8_BAR; PG8_SCHED;
            PG8_STAGE(PG8_SB(0, 1), b2 + hstep, voffB);
            PG8_WAIT_V(6); PG8_BAR; PG8_MMA(1, 1, At, B1); PG8_BAR;
            PG8_LDB(B0, 1, 0); PG8_SCHED; PG8_LDA(At, 1, 0); PG8_STAGE(PG8_SA(0, 1), a2 + hstep, voffA);
            PG8_WAIT_L(8); PG8_BAR; PG8_WAIT_L(0); PG8_MMA(0, 0, At, B0); PG8_BAR; PG8_SCHED;
            PG8_LDB(B1, 1, 1); PG8_STAGE(PG8_SB(1, 0), b3, voffB);
            PG8_BAR; PG8_WAIT_L(0); PG8_MMA(0, 1, At, B1); PG8_BAR;
            PG8_LDA(At, 1, 1); PG8_STAGE(PG8_SA(1, 0), a3, voffA);
            PG8_BAR; PG8_WAIT_L(0); PG8_MMA(1, 0, At, B0); PG8_BAR; PG8_SCHED;
            PG8_STAGE(PG8_SB(1, 1), b3 + hstep, voffB);
            PG8_WAIT_V(6); PG8_BAR; PG8_MMA(1, 1, At, B1); PG8_BAR;
            }
        }
        if constexpr (ALIGN_EPI) { if (wr == 0) PG8_BAR; }
        if constexpr (!Epi::AFTER_DRAIN) { E(acc, cur, wr, wc, fr, fq); S.done(cur); }
        if (!has_next) break;
#pragma unroll
        for (int a = 0; a < 2; ++a)
#pragma unroll
            for (int b = 0; b < 2; ++b)
#pragma unroll
                for (int m = 0; m < 4; ++m)
#pragma unroll
                    for (int n = 0; n < 2; ++n) acc[a][b][m][n] = (f32x4){0.f, 0.f, 0.f, 0.f};
        cur = nxt; cA = nA; cB = nB; ++ui;
        if constexpr (ALIGN_EPI) { if (wr == 1) PG8_BAR; }
    }
    PG8_WAIT_V(0);
    if constexpr (!ALIGN_EPI) { if (wr == 0) PG8_BAR; }
    PG8_BAR;
    if constexpr (Epi::AFTER_DRAIN) { E.fused(acc, cur, wr, wc, fr, fq, lds, wid, lane); S.done(cur); }
#undef PG8_SA
#undef PG8_SB
#undef PG8_STAGE
#undef PG8_LDA
#undef PG8_LDB
#undef PG8_MMA
#undef PG8_WAIT_V
#undef PG8_WAIT_L
#undef PG8_BAR
#undef PG8_SCHED
}
}
#define GAS __attribute__((address_space(1)))
#define LAS __attribute__((address_space(3)))
typedef unsigned short bf16;
typedef unsigned v4u __attribute__((ext_vector_type(4)));
typedef float f32x4 __attribute__((ext_vector_type(4)));
typedef short bf16x8 __attribute__((ext_vector_type(8)));
typedef GAS unsigned gu32;
typedef GAS unsigned long long gu64;
#define RLX_AGENT __ATOMIC_RELAXED, __HIP_MEMORY_SCOPE_AGENT
#define LDS_WAIT() asm volatile("s_waitcnt lgkmcnt(0)" ::: "memory")
#define VM_WAIT() asm volatile("s_waitcnt vmcnt(0)" ::: "memory")
__device__ __forceinline__ unsigned long long rt() { return __builtin_amdgcn_s_memrealtime(); }
__device__ __forceinline__ unsigned f2bf(float f) { unsigned u = __builtin_bit_cast(unsigned, f); return (u + 0x7fffu + ((u >> 16) & 1u)) >> 16; }
__device__ __forceinline__ unsigned pk2(float lo, float hi) { return f2bf(lo) | (f2bf(hi) << 16); }
#define XB_TMO      128
#define XB_XCNT(j)  (256  + 64 * (j))
#define XB_XSUB(j)  (1280 + 64 * (j))
#define XB_XGEN(j)  (2304 + 64 * (j))
#define XB_TOP      3328
#define XB_TOPGEN   3392
#define XCD_BAR_WORDS 3456
#define XB_SPIN_CAP (1u << 18)

__device__ __forceinline__ unsigned xb_ld(unsigned* p)              { return __hip_atomic_load(p, __ATOMIC_RELAXED, __HIP_MEMORY_SCOPE_AGENT); }
__device__ __forceinline__ unsigned xb_add(unsigned* p, unsigned v) { return __hip_atomic_fetch_add(p, v, __ATOMIC_RELAXED, __HIP_MEMORY_SCOPE_AGENT); }
__device__ __forceinline__ unsigned xb_xcc_id() { return (unsigned)__builtin_amdgcn_s_getreg((3 << 11) | 20) & 0xFu; }
#define XB_SPIN(cond, bar) do { unsigned _sp = 0; while (cond) { __builtin_amdgcn_s_sleep(1); \
    if ((++_sp & 255u) == 0u) { if (xb_ld(&(bar)[XB_TMO])) break; if (_sp > XB_SPIN_CAP) { atomicAdd(&(bar)[XB_TMO], 1u); break; } } } } while (0)

struct XcdBarrier {
    unsigned* bar; unsigned x;
    volatile LAS unsigned* st;
};

__device__ __forceinline__ XcdBarrier xcd_barrier_post(unsigned* bar, volatile LAS unsigned* st) {
    XcdBarrier b; b.bar = bar; b.x = xb_xcc_id(); b.st = st;
    if (threadIdx.x == 0) (void)xb_add(&bar[XB_XCNT(b.x)], 1u);
    return b;
}
__device__ __forceinline__ void xcd_barrier_complete(unsigned* bar, unsigned x, unsigned& nloc, unsigned& nx) {
    const unsigned G = gridDim.x * gridDim.y * gridDim.z;
    unsigned sum, cnt, mine, sp = 0u;
    for (;;) {
        sum = 0u; cnt = 0u; mine = 0u;
#pragma unroll
        for (unsigned j = 0; j < 16; ++j) { const unsigned c = xb_ld(&bar[XB_XCNT(j)]); sum += c; cnt += (c > 0u) ? 1u : 0u; mine = (j == x) ? c : mine; }
        if (sum == G) break;
        __builtin_amdgcn_s_sleep(1);
        if ((++sp & 255u) == 0u) { if (xb_ld(&bar[XB_TMO])) break; if (sp > XB_SPIN_CAP) { atomicAdd(&bar[XB_TMO], 1u); break; } }
    }
    nloc = mine > 0u ? mine : 1u; nx = cnt > 0u ? cnt : 1u;
}

__device__ __forceinline__ void xcd_barrier(const XcdBarrier& b) {
    asm volatile("s_waitcnt vmcnt(0)" ::: "memory");
    __syncthreads();
    if (threadIdx.x == 0) {
        unsigned* bar = b.bar;
        __builtin_amdgcn_s_waitcnt(0);
        unsigned nloc = b.st[0], nx = b.st[1];
        if (nloc == 0u) { xcd_barrier_complete(bar, b.x, nloc, nx); b.st[0] = nloc; b.st[1] = nx; }
        const unsigned old = xb_add(&bar[XB_XSUB(b.x)], 1u);
        const unsigned gen = old / nloc;
        if (old + 1u == (gen + 1u) * nloc) {
            __builtin_amdgcn_fence(__ATOMIC_RELEASE, "agent");
            asm volatile("s_waitcnt vmcnt(0)" ::: "memory");
            const unsigned og = xb_add(&bar[XB_TOP], 1u);
            const unsigned tg = og / nx;
            if (og + 1u == (tg + 1u) * nx) xb_add(&bar[XB_TOPGEN], 1u);
            else XB_SPIN(xb_ld(&bar[XB_TOPGEN]) == tg, bar);
            __builtin_amdgcn_fence(__ATOMIC_ACQUIRE, "agent");
            xb_add(&bar[XB_XGEN(b.x)], 1u);
            asm volatile("s_waitcnt vmcnt(0)" ::: "memory");
        } else {
            XB_SPIN(xb_ld(&bar[XB_XGEN(b.x)]) == gen, bar);
            __builtin_amdgcn_fence(__ATOMIC_ACQUIRE, "agent");
            asm volatile("s_waitcnt vmcnt(0)" ::: "memory");
        }
    }
    __syncthreads();
}

namespace sba {
#define LAS3 __attribute__((address_space(3)))
typedef short bf16x8 __attribute__((ext_vector_type(8)));
typedef short s16x4 __attribute__((ext_vector_type(4)));
typedef float f32x16 __attribute__((ext_vector_type(16)));
typedef unsigned u32x4 __attribute__((ext_vector_type(4)));
typedef short v4i16_t __attribute__((ext_vector_type(4)));
typedef unsigned short bf16;
constexpr int SEQ = 2048, PITCH = 512, HD = 64;
__host__ __device__ __forceinline__ constexpr int crow(int r, int hi) { return (r & 3) + 8 * (r >> 2) + 4 * hi; }
__device__ __forceinline__ unsigned cvtpk(float lo, float hi) { unsigned r; asm volatile("v_cvt_pk_bf16_f32 %0, %1, %2" : "=v"(r) : "v"(lo), "v"(hi)); return r; }
__device__ __forceinline__ s16x4 vtr(LAS3 const unsigned char* p) { return __builtin_bit_cast(s16x4, __builtin_amdgcn_ds_read_tr16_b64_v4i16((LAS3 v4i16_t*)p)); }

template <bool PARTIAL>
__device__ __forceinline__ void tile(f32x16 (&o)[2], float& carry, const bf16x8 (&qr)[4], LAS3 const unsigned char* Kslot, LAS3 const unsigned char* Vslot, int lim, int r32, int hi, int lane) {
    f32x16 p0 = {}, p1 = {};
    LAS3 const unsigned char* kb = Kslot + hi * 1024 + r32 * 16;
#pragma unroll
    for (int d0 = 0; d0 < 4; ++d0) {
        const bf16x8 b0 = *(LAS3 const bf16x8*)(kb + d0 * 2048), b1 = *(LAS3 const bf16x8*)(kb + d0 * 2048 + 512);
        p0 = __builtin_amdgcn_mfma_f32_32x32x16_bf16(b0, qr[d0], p0, 0, 0, 0);
        p1 = __builtin_amdgcn_mfma_f32_32x32x16_bf16(b1, qr[d0], p1, 0, 0, 0);
    }
    float kp[32], be[32];
#pragma unroll
    for (int i = 0; i < 32; ++i) {
        const float z = i < 16 ? p0[i] : p1[i - 16];
        const float t = __builtin_amdgcn_exp2f(-__builtin_fabsf(z));
        const float rr = __builtin_amdgcn_rcpf(1.0f + t), uu = t * rr;
        const bool pos = z >= 0.f;
        float b_ = pos ? rr : uu, k_ = pos ? uu : rr;
        if (PARTIAL) { const int c = crow(i & 15, 0) + (i >> 4) * 32; const bool valid = c < lim; b_ = valid ? b_ : 0.f; k_ = valid ? k_ : 1.f; }
        be[i] = b_; kp[i] = k_;
    }
    float E[16];
#pragma unroll
    for (int g = 0; g < 8; ++g) {
        const float gp = (kp[4 * g] * kp[4 * g + 1]) * (kp[4 * g + 2] * kp[4 * g + 3]);
        auto rr = __builtin_amdgcn_permlane32_swap(__float_as_uint(gp), __float_as_uint(gp), false, false);
        E[2 * g] = __uint_as_float(rr[0]); E[2 * g + 1] = __uint_as_float(rr[1]);
    }
    float SP[16]; SP[15] = carry;
#pragma unroll
    for (int k = 14; k >= 0; --k) SP[k] = SP[k + 1] * E[k + 1];
    carry = SP[0] * E[0];
    float a[32];
#pragma unroll
    for (int g = 0; g < 8; ++g) {
        float x = hi ? SP[2 * g + 1] : SP[2 * g];
        a[4 * g + 3] = be[4 * g + 3] * x; x *= kp[4 * g + 3];
        a[4 * g + 2] = be[4 * g + 2] * x; x *= kp[4 * g + 2];
        a[4 * g + 1] = be[4 * g + 1] * x; x *= kp[4 * g + 1];
        a[4 * g] = be[4 * g] * x;
    }
    u32x4 pw[4];
#pragma unroll
    for (int ks = 0; ks < 4; ++ks) { pw[ks].x = cvtpk(a[8 * ks], a[8 * ks + 1]); pw[ks].y = cvtpk(a[8 * ks + 2], a[8 * ks + 3]); pw[ks].z = cvtpk(a[8 * ks + 4], a[8 * ks + 5]); pw[ks].w = cvtpk(a[8 * ks + 6], a[8 * ks + 7]); }
    LAS3 const unsigned char* vb = Vslot + ((lane >> 4) & 1) * 32 + (lane & 3) * 8 + (4 * hi + ((lane & 15) >> 2)) * 64;
#pragma unroll
    for (int d0 = 0; d0 < 2; ++d0)
#pragma unroll
        for (int ks = 0; ks < 4; ++ks) {
            const s16x4 lo = vtr(vb + d0 * 4096 + ks * 1024), h4 = vtr(vb + d0 * 4096 + ks * 1024 + 512);
            const bf16x8 vf = (bf16x8){lo[0], lo[1], lo[2], lo[3], h4[0], h4[1], h4[2], h4[3]};
            o[d0] = __builtin_amdgcn_mfma_f32_32x32x16_bf16(__builtin_bit_cast(bf16x8, pw[ks]), vf, o[d0], 0, 0, 0);
        }
}

__device__ __forceinline__ void attn_unit(int b, int h, int qb, const bf16* Q, const bf16* K, const bf16* V, bf16* O, LAS3 unsigned char* lds) {
    const int tid = ltid(), lane = tid & 63, r32 = lane & 31, hi = lane >> 5; const int wid = __builtin_amdgcn_readfirstlane(tid >> 6);
    const size_t rowbase = (size_t)b * SEQ; const int q0 = qb * 256;
    const int myq = q0 + wid * 32 + r32;
    const bf16* Qw = Q + (rowbase + myq) * PITCH + h * HD;
    bf16x8 qr[4];
#pragma unroll
    for (int d0 = 0; d0 < 4; ++d0) qr[d0] = *(const bf16x8*)(Qw + d0 * 16 + hi * 8);
    const bf16* ksrc = K + (rowbase + lane) * PITCH + h * HD + wid * 8;
    const bf16* vsrc = V + (rowbase + 16 * (wid & 3) + (lane >> 2)) * PITCH + h * HD + (wid >> 2) * 32 + (lane & 3) * 8;
    const int stoff = wid * 1024 + lane * 16;
    const int NT = 4 * qb + 4;
    u32x4 kreg = *(const u32x4*)(ksrc + (size_t)(NT - 1) * 64 * PITCH), vreg = *(const u32x4*)(vsrc + (size_t)(NT - 1) * 64 * PITCH);
    *(LAS3 u32x4*)(lds + stoff) = kreg; *(LAS3 u32x4*)(lds + 16384 + stoff) = vreg;
    __syncthreads();
    f32x16 o[2]; o[0] = f32x16{}; o[1] = f32x16{};
    float carry = 1.f; int buf = 0;
    const int tmin = q0 + wid * 32, tmax = tmin + 31;
    for (int j = NT - 1; j >= 0; --j) {
        if (j > 0) { kreg = *(const u32x4*)(ksrc + (size_t)(j - 1) * 64 * PITCH); vreg = *(const u32x4*)(vsrc + (size_t)(j - 1) * 64 * PITCH); }
        if (64 * j < tmax) {
            const int lim = myq - 64 * j - 4 * hi;
            if (64 * j + 63 >= tmin) tile<true>(o, carry, qr, lds + buf * 8192, lds + 16384 + buf * 8192, lim, r32, hi, lane);
            else tile<false>(o, carry, qr, lds + buf * 8192, lds + 16384 + buf * 8192, lim, r32, hi, lane);
        }
        if (j > 0) { *(LAS3 u32x4*)(lds + (buf ^ 1) * 8192 + stoff) = kreg; *(LAS3 u32x4*)(lds + 16384 + (buf ^ 1) * 8192 + stoff) = vreg; }
        __syncthreads();
        buf ^= 1;
    }
    bf16* Ow = O + (rowbase + q0 + wid * 32) * PITCH + h * HD + r32;
#pragma unroll
    for (int r = 0; r < 16; ++r) { const int orow = crow(r, 0) + 4 * hi;
#pragma unroll
        for (int d0 = 0; d0 < 2; ++d0) Ow[(size_t)orow * PITCH + d0 * 32] = (bf16)(cvtpk(o[d0][r], 0.f) & 0xffffu); }
}
}

constexpr int NWAVES = 8;
constexpr int BATCH = 8, SEQ = 2048, D = 1024, DEPTH = 2, FF = 2816, NIN = 5120;
constexpr int M = BATCH * SEQ;
constexpr int N_PHASES = 9 * DEPTH + 1;
#ifndef MK_PER_PHASE
#define MK_PER_PHASE 1
#endif
constexpr size_t KiB = 1024, MiB = 1u << 20;
constexpr size_t WS_CTL = 0, CTL_ZERO_BYTES = 64 * KiB;
constexpr size_t WS_SSQ = 1 * MiB;
constexpr size_t WS_W13A = 2048 * KiB, WS_W2A = 13312 * KiB, WS_WIN = 18944 * KiB, WS_WC = 29184 * KiB, WS_WA = 30208 * KiB, WS_WO = 31232 * KiB, WS_W13B = 33280 * KiB, WS_W2B = 44544 * KiB;
constexpr size_t WS_XB = 49 * MiB;
constexpr size_t WS_ACT = 81 * MiB;
constexpr size_t WS_CB = 81 * MiB, WS_U = 97 * MiB, WS_Q = 113 * MiB, WS_K = 129 * MiB, WS_V = 145 * MiB, WS_G = 161 * MiB, WS_MG = 129 * MiB, WS_END = 225 * MiB;
static_assert(WS_SSQ == pg8::EWS_SSQ && WS_XB == pg8::EWS_XB && WS_ACT == pg8::EWS_ACT && WS_CB == pg8::EWS_CB && WS_U == pg8::EWS_U && WS_Q == pg8::EWS_Q && WS_K == pg8::EWS_K && WS_V == pg8::EWS_V && WS_G == pg8::EWS_G && WS_MG == pg8::EWS_MG, "d_ws map shared with the epilogue");
static_assert(WS_W2B + (size_t)D * FF * 2 <= WS_XB && WS_ACT + (size_t)M * FF * 2 <= 256 * MiB && WS_G + (size_t)M * 2048 * 2 <= WS_END, "d_ws map");
constexpr int CW_BAR = 4096;
constexpr int RING_BYTES = 131072, LDSCTL_OFF = RING_BYTES, MISC_OFF = LDSCTL_OFF + 320, LDS_BYTES = 147456;

__device__ __forceinline__ float wave_sum(float v) {
#pragma unroll
    for (int o = 1; o < 64; o <<= 1) v += __shfl_xor(v, o);
    return v;
}
__device__ __forceinline__ int maprow(int mode, int n) {
    if (mode == 1) { if (n < FF) return 256 * (n / 128) + (n % 128); const int j = n - FF; return 256 * (j / 128) + 128 + (j % 128); }
    if (mode == 2) { if (n < 512 || n >= 1536) return n; const int j = (n - 512) & 511, second = (n >= 1024) ? 128 : 0; return 512 + 256 * (j / 128) + second + (j % 128); }
    return n;
}
__device__ __forceinline__ void transpose_item(const float* W, int K, int N, bf16* WT, const float* gain, int mode, LAS float* scr, int item, int lane) {
    const int nblk = N / 32, kb = item / nblk, nb = item % nblk, k0 = 64 * kb, n0 = 32 * nb;
#pragma unroll 8
    for (int i = 0; i < 32; ++i) { const int kk = 2 * i + (lane >> 5); float w = W[(size_t)(k0 + kk) * N + n0 + (lane & 31)]; if (gain) w *= gain[k0 + kk]; scr[kk * 33 + (lane & 31)] = w; }
    LDS_WAIT(); asm volatile("" ::: "memory");
    const int c = lane & 7, nd0 = maprow(mode, n0);
#pragma unroll
    for (int j = 0; j < 4; ++j) { const int n = (lane >> 3) + 8 * j; const LAS float* s = scr + (8 * c) * 33 + n;
        v4u o; o.x = pk2(s[0 * 33], s[1 * 33]); o.y = pk2(s[2 * 33], s[3 * 33]); o.z = pk2(s[4 * 33], s[5 * 33]); o.w = pk2(s[6 * 33], s[7 * 33]);
        *(GAS v4u*)(WT + (size_t)(nd0 + n) * K + k0 + 8 * c) = o; }
    LDS_WAIT(); asm volatile("" ::: "memory");
}

struct Args { const float* in[15]; float* out; unsigned char* ws; int ph_lo, ph_hi, coop, pad; };

__global__ void __launch_bounds__(NWAVES * 64, 2) fwd_kernel(Args args_) {
    extern __shared__ __attribute__((aligned(16))) unsigned char lds[];
    {   LAS unsigned char* L0 = (LAS unsigned char*)lds;
        for (int u = threadIdx.x; u < (LDS_BYTES - LDSCTL_OFF) / 4; u += NWAVES * 64) ((LAS unsigned*)(L0 + LDSCTL_OFF))[u] = 0u;
        __syncthreads();
        if (args_.ph_hi - args_.ph_lo > 1) (void)xcd_barrier_post((unsigned*)(args_.ws + WS_CTL) + CW_BAR, (volatile LAS unsigned*)(L0 + MISC_OFF) + 8); }
    const int lo = args_.ph_lo, hi = args_.ph_hi;
    for (int ph = lo; ph < hi; ++ph) {
        const __attribute__((address_space(4))) Args* ap = (const __attribute__((address_space(4))) Args*)__builtin_amdgcn_kernarg_segment_ptr();
        asm volatile("" : "+s"(ap));
        const __attribute__((address_space(4))) Args& args = *ap;
        LAS unsigned char* L = (LAS unsigned char*)lds;
        const int tid = ltid(), lane = tid & 63, wave = __builtin_amdgcn_readfirstlane(tid >> 6);
        const int G = gridDim.x, bid = blockIdx.x;
        const int vcu = (G % 8 == 0) ? (bid % 8) * (G / 8) + bid / 8 : bid;
        unsigned char* ws = args.ws;
        const int gw = vcu * NWAVES + wave, NGW = G * NWAVES;
        const int l = ph / 9, s = ph % 9;
        if (ph == N_PHASES - 1) {
            const float* gfin = args.in[14]; float* const out = args.out;
            for (int m = gw; m < M; m += NGW) { GAS f32x4* xr = (GAS f32x4*)(out + (size_t)m * D) + lane; f32x4 v[4]; float sq = 0.f;
#pragma unroll
                for (int j = 0; j < 4; ++j) { v[j] = xr[64 * j]; sq += (v[j].x * v[j].x + v[j].y * v[j].y) + (v[j].z * v[j].z + v[j].w * v[j].w); }
                const float rs = 1.0f / sqrtf(wave_sum(sq) * (1.0f / D) + 1e-6f);
#pragma unroll
                for (int j = 0; j < 4; ++j) { const f32x4 gg = *((const f32x4*)gfin + 64 * j + lane); xr[64 * j] = v[j] * rs * gg; } }
        } else if (s == 0) {
            LAS float* scr = (LAS float*)(L + wave * 16384);
            const float* w13a = args.in[2] + (size_t)l * D * 2 * FF; const float* w2a = args.in[3] + (size_t)l * FF * D; const float* win = args.in[5] + (size_t)l * D * NIN;
            const float* wc = args.in[8] + (size_t)l * 512 * D; const float* wa = args.in[9] + (size_t)l * 512 * D; const float* wo = args.in[10] + (size_t)l * D * D;
            const float* w13b = args.in[12] + (size_t)l * D * 2 * FF; const float* w2b = args.in[13] + (size_t)l * FF * D;
            const float* g1 = args.in[1] + l * D; const float* gm = args.in[4] + l * D; const float* g2 = args.in[11] + l * D;
            constexpr int I13 = (D / 64) * (2 * FF / 32), I2 = (FF / 64) * (D / 32), IIN = (D / 64) * (NIN / 32), ICO = (512 / 64) * (D / 32), IO = (D / 64) * (D / 32);
            constexpr int NITEMS = 2 * I13 + 2 * I2 + IIN + 2 * ICO + IO;
            for (int it = gw; it < NITEMS; it += NGW) {
                int r = it;
                if (r < I13) { transpose_item(w13a, D, 2 * FF, (bf16*)(ws + WS_W13A), g1, 1, scr, r, lane); continue; } r -= I13;
                if (r < I13) { transpose_item(w13b, D, 2 * FF, (bf16*)(ws + WS_W13B), g2, 1, scr, r, lane); continue; } r -= I13;
                if (r < IIN) { transpose_item(win, D, NIN, (bf16*)(ws + WS_WIN), gm, 2, scr, r, lane); continue; } r -= IIN;
                if (r < I2) { transpose_item(w2a, FF, D, (bf16*)(ws + WS_W2A), nullptr, 0, scr, r, lane); continue; } r -= I2;
                if (r < I2) { transpose_item(w2b, FF, D, (bf16*)(ws + WS_W2B), nullptr, 0, scr, r, lane); continue; } r -= I2;
                if (r < IO) { transpose_item(wo, D, D, (bf16*)(ws + WS_WO), nullptr, 0, scr, r, lane); continue; } r -= IO;
                if (r < ICO) { transpose_item(wc, 512, D, (bf16*)(ws + WS_WC), nullptr, 0, scr, r, lane); continue; } r -= ICO;
                transpose_item(wa, 512, D, (bf16*)(ws + WS_WA), nullptr, 0, scr, r, lane);
            }
            if (l == 0) {
                const float* x = args.in[0]; bf16* const XB = (bf16*)(ws + WS_XB); float* const ssq = (float*)(ws + WS_SSQ);
                for (int m = gw; m < M; m += NGW) { const GAS f32x4* xr = (const GAS f32x4*)(x + (size_t)m * D) + lane; f32x4 v[4]; float sq = 0.f;
#pragma unroll
                    for (int j = 0; j < 4; ++j) { v[j] = xr[64 * j]; sq += (v[j].x * v[j].x + v[j].y * v[j].y) + (v[j].z * v[j].z + v[j].w * v[j].w); }
                    sq = wave_sum(sq);
                    GAS unsigned long long* o8 = (GAS unsigned long long*)(XB + (size_t)m * D) + lane;
#pragma unroll
                    for (int j = 0; j < 4; ++j) o8[64 * j] = (unsigned long long)pk2(v[j].x, v[j].y) | ((unsigned long long)pk2(v[j].z, v[j].w) << 32);
                    if (lane < 16) ssq[(size_t)m * 16 + lane] = lane == 0 ? sq : 0.f; }
            }
        } else if (s == 4) {
            const float* cw = args.in[7] + (size_t)l * 3 * 512;
            bf16* const CB = (bf16*)(ws + WS_CB); bf16* const U = (bf16*)(ws + WS_U); bf16* const Qb = (bf16*)(ws + WS_Q); bf16* const Kb = (bf16*)(ws + WS_K); bf16* const Vb = (bf16*)(ws + WS_V);
            for (int i = bid * (NWAVES * 64) + tid; i < M * 64; i += G * NWAVES * 64) { const int row = i >> 6, c0 = (i & 63) * 8, t = row & (SEQ - 1);
                const pg8::u32x4e zero4 = {0u, 0u, 0u, 0u};
                const pg8::u32x4e cbv = *(const pg8::u32x4e*)(CB + (size_t)row * 512 + c0), u2 = *(const pg8::u32x4e*)(U + (size_t)row * 512 + c0);
                const pg8::u32x4e u1 = t >= 1 ? *(const pg8::u32x4e*)(U + (size_t)(row - 1) * 512 + c0) : zero4, u0 = t >= 2 ? *(const pg8::u32x4e*)(U + (size_t)(row - 2) * 512 + c0) : zero4;
                f32x4 cb0, cb1, a0, a1, b0, b1, c0v, c1v; pg8::unpack8(cbv, cb0, cb1); pg8::unpack8(u0, a0, a1); pg8::unpack8(u1, b0, b1); pg8::unpack8(u2, c0v, c1v);
                const f32x4 w00 = *(const f32x4*)(cw + c0), w01 = *(const f32x4*)(cw + c0 + 4), w10 = *(const f32x4*)(cw + 512 + c0), w11 = *(const f32x4*)(cw + 512 + c0 + 4), w20 = *(const f32x4*)(cw + 1024 + c0), w21 = *(const f32x4*)(cw + 1024 + c0 + 4);
                const f32x4 y0 = cb0 * (w00 * a0 + w10 * b0 + w20 * c0v), y1 = cb1 * (w01 * a1 + w11 * b1 + w21 * c1v);
                *(pg8::u32x4e*)(CB + (size_t)row * 512 + c0) = pg8::pack8(y0, y1); }
            __syncthreads();
            for (int p = vcu; p < 256; p += G) { const int bh = p >> 2, sI = p & 3;
                sba::attn_unit(bh >> 3, bh & 7, 7 - sI, Qb, Kb, Vb, Qb, L);
                sba::attn_unit(bh >> 3, bh & 7, sI, Qb, Kb, Vb, Qb, L); }
        } else {
            const int ncall = (s == 5) ? 2 : 1;
            for (int c = 0; c < ncall; ++c) {
                pg8::Gemm g{}; pg8::EpiAll E{};
                E.ws = ws; E.outf = args.out; E.base = args.out; E.alpha = 0.5f; E.bgate = args.in[6] + (size_t)l * 2048;
                g.M = M;
                if (s == 1)      { g.A = (const bf16*)(ws + WS_XB);  g.Bt = (const bf16*)(ws + WS_W13A); g.N = 2 * FF; g.K = D;  E.mode = pg8::EP_SWIGLU; }
                else if (s == 2) { g.A = (const bf16*)(ws + WS_ACT); g.Bt = (const bf16*)(ws + WS_W2A);  g.N = D;      g.K = FF; E.mode = pg8::EP_RESID; if (l == 0) E.base = args.in[0]; }
                else if (s == 3) { g.A = (const bf16*)(ws + WS_XB);  g.Bt = (const bf16*)(ws + WS_WIN);  g.N = NIN;    g.K = D;  E.mode = pg8::EP_WIN; }
                else if (s == 5) { if (c == 0) { g.A = (const bf16*)(ws + WS_Q); g.Bt = (const bf16*)(ws + WS_WA); E.mode = pg8::EP_MERGE1; } else { g.A = (const bf16*)(ws + WS_CB); g.Bt = (const bf16*)(ws + WS_WC); E.mode = pg8::EP_MERGE2; } g.N = D; g.K = 512; }
                else if (s == 6) { g.A = (const bf16*)(ws + WS_MG);  g.Bt = (const bf16*)(ws + WS_WO);   g.N = D;      g.K = D;  E.mode = pg8::EP_RESID; E.alpha = 1.0f; }
                else if (s == 7) { g.A = (const bf16*)(ws + WS_XB);  g.Bt = (const bf16*)(ws + WS_W13B); g.N = 2 * FF; g.K = D;  E.mode = pg8::EP_SWIGLU; }
                else             { g.A = (const bf16*)(ws + WS_ACT); g.Bt = (const bf16*)(ws + WS_W2B);  g.N = D;      g.K = FF; E.mode = pg8::EP_RESID; }
                pg8::StaticOrder S; S.init(M, g.N, G, bid);
                pg8::gemm_phase<pg8::EpiAll, pg8::StaticOrder, true, true>(L, g, S, E);
            }
        }
        if (ph + 1 < hi) {
            if (ph == lo && args.coop) { __threadfence(); cg::this_grid().sync(); }
            else { XcdBarrier bar; bar.bar = (unsigned*)(ws + WS_CTL) + CW_BAR; bar.x = xb_xcc_id(); bar.st = (volatile LAS unsigned*)(L + MISC_OFF) + 8; xcd_barrier(bar); }
        }
    }
}

extern "C" void kernel_launch(void* const* d_in, const int* in_sizes, int n_in, void* d_out, int out_size, void* d_ws, size_t ws_size, hipStream_t stream) {
    static int grid = 0;
    if (grid == 0) {
        if (n_in != 15 || in_sizes[0] != M * D || out_size != M * D || ws_size < WS_END) { fprintf(stderr, "kernel_launch: unexpected shapes (n_in %d, in0 %d, out %d, ws %zu); nothing launched\n", n_in, n_in > 0 ? in_sizes[0] : -1, out_size, ws_size); grid = -1; return; }
        int dev = 0, cus = 0, per_cu = 0;
        if (hipGetDevice(&dev) != hipSuccess || hipDeviceGetAttribute(&cus, hipDeviceAttributeMultiprocessorCount, dev) != hipSuccess) { grid = -1; return; }
        if (hipFuncSetAttribute((const void*)fwd_kernel, hipFuncAttributeMaxDynamicSharedMemorySize, LDS_BYTES) != hipSuccess) { fprintf(stderr, "kernel_launch: hipFuncSetAttribute failed\n"); grid = -1; return; }
        if (hipOccupancyMaxActiveBlocksPerMultiprocessor(&per_cu, (const void*)fwd_kernel, NWAVES * 64, LDS_BYTES) != hipSuccess || per_cu < 1) { fprintf(stderr, "kernel_launch: occupancy query says %d blocks per CU; nothing launched\n", per_cu); (void)hipGetLastError(); grid = -1; return; }
        grid = cus < 256 ? cus : 256;
    }
    if (grid < 0) return;
    if (hipMemsetAsync((char*)d_ws + WS_CTL, 0, CTL_ZERO_BYTES, stream) != hipSuccess) { fprintf(stderr, "kernel_launch: hipMemsetAsync failed\n"); return; }
    Args a{};
    for (int i = 0; i < 15; ++i) a.in[i] = (const float*)d_in[i];
    a.out = (float*)d_out; a.ws = (unsigned char*)d_ws;
#if MK_PER_PHASE
    for (int ph = 0; ph < N_PHASES; ++ph) { a.ph_lo = ph; a.ph_hi = ph + 1; a.coop = 0;
        hipLaunchKernelGGL(fwd_kernel, dim3(grid), dim3(NWAVES * 64), LDS_BYTES, stream, a); }
#else
    a.ph_lo = 0; a.ph_hi = N_PHASES; a.coop = 1;
    void* kargs[] = {&a};
    const hipError_t e = hipLaunchCooperativeKernel((const void*)fwd_kernel, dim3(grid), dim3(NWAVES * 64), kargs, LDS_BYTES, stream);
    if (e != hipSuccess) fprintf(stderr, "kernel_launch: cooperative launch failed: %s (grid %d)\n", hipGetErrorString(e), grid);
#endif
}
```

```cpp
#include <hip/hip_runtime.h>
#include <hip/hip_cooperative_groups.h>
#include <cstdio>
#include <cstdint>
namespace cg = cooperative_groups;
__device__ __forceinline__ int ltid() { int t = threadIdx.x; asm volatile("" : "+v"(t)); return t; }
namespace pg8 {
#define PG8_LAS __attribute__((address_space(3)))
typedef unsigned short bf16_t;
typedef short bf16x8 __attribute__((ext_vector_type(8)));
typedef float f32x4 __attribute__((ext_vector_type(4)));
typedef unsigned u32x4 __attribute__((ext_vector_type(4)));
constexpr int BM = 256, BK = 64, HALF = 128, HTB = HALF * BK * 2  , STAGE_BYTES = 8 * HTB, NXCD = 8, WGM = 8;

__host__ __device__ __forceinline__ int lds_byte(int r, int c) { const int st = (r >> 4) * 2 + (c >> 5), rr = r & 15, cc = c & 31, ob = rr * 64 + cc * 2; return st * 1024 + (ob ^ (((ob >> 9) & 1) << 5)); }
__host__ __device__ __forceinline__ void stage_rc(int b, int& R, int& C) { const int st = b / 1024, sb = b % 1024, swz = sb ^ (((sb >> 9) & 1) << 5); R = (st >> 1) * 16 + swz / 64; C = (st & 1) * 32 + (swz % 64) / 2; }
__host__ __device__ __forceinline__ int perm32(int rho) { const int n = rho >> 4, i = rho & 15; return 8 * (i >> 2) + 4 * n + (i & 3); }

struct Unit { int pm, pn; };
struct Gemm { const bf16_t* A; const bf16_t* Bt; int M, N, K; };

struct StaticOrder {
    int nM, nN, nwg, G, c;
    __host__ __device__ void init(int M, int N, int G_, int c_) { nM = M / BM; nN = N / BM; nwg = nM * nN; G = G_; c = c_; }
    __host__ __device__ bool next(int i, Unit& u) const {
        const long L = (long)i * G + c; if (L >= nwg) return false;
        int wgid = (int)L; { const int q = nwg / NXCD, r = nwg % NXCD, xcd = wgid % NXCD, off = wgid / NXCD; wgid = (xcd < r ? xcd * (q + 1) : r * (q + 1) + (xcd - r) * q) + off; }
        const int nig = WGM * nN, gid = wgid / nig, fm = gid * WGM, gsz = (nM - fm) < WGM ? (nM - fm) : WGM;
        u.pm = fm + ((wgid % nig) % gsz); u.pn = (wgid % nig) / gsz; return true;
    }
    __device__ __forceinline__ void a_ready(const Unit&) const {}
    __device__ __forceinline__ void done(const Unit&) const {}
};

__device__ __forceinline__ unsigned cvt_pk_bf16(float lo, float hi) { unsigned r; asm volatile("v_cvt_pk_bf16_f32 %0, %1, %2" : "=v"(r) : "v"(lo), "v"(hi)); return r; }
typedef float f32x2 __attribute__((ext_vector_type(2)));

typedef unsigned u32x4e __attribute__((ext_vector_type(4)));
constexpr float LOG2E = 1.4426950408889634f;
constexpr float QSCALE = 0.125f * LOG2E;
__device__ __forceinline__ float rowscale(const float* ssq, int row) {
    const f32x4* p = (const f32x4*)(ssq + (size_t)row * 16);
    const f32x4 s = (p[0] + p[1]) + (p[2] + p[3]);
    return __builtin_amdgcn_rsqf(((s[0] + s[1]) + (s[2] + s[3])) * (1.0f / 1024.0f) + 1e-6f);
}
__device__ __forceinline__ float sigmoid_f(float x) { return __builtin_amdgcn_rcpf(1.0f + __builtin_amdgcn_exp2f(-x * LOG2E)); }
__device__ __forceinline__ u32x4e pack8(const f32x4 a, const f32x4 b) { u32x4e w; w.x = cvt_pk_bf16(a[0], a[1]); w.y = cvt_pk_bf16(a[2], a[3]); w.z = cvt_pk_bf16(b[0], b[1]); w.w = cvt_pk_bf16(b[2], b[3]); return w; }
__device__ __forceinline__ void unpack8(const u32x4e w, f32x4& a, f32x4& b) {
    a[0] = __uint_as_float(w.x << 16); a[1] = __uint_as_float(w.x & 0xffff0000u); a[2] = __uint_as_float(w.y << 16); a[3] = __uint_as_float(w.y & 0xffff0000u);
    b[0] = __uint_as_float(w.z << 16); b[1] = __uint_as_float(w.z & 0xffff0000u); b[2] = __uint_as_float(w.w << 16); b[3] = __uint_as_float(w.w & 0xffff0000u);
}
constexpr size_t EMiB = 1u << 20;
constexpr size_t EWS_SSQ = 1 * EMiB, EWS_XB = 49 * EMiB, EWS_ACT = 81 * EMiB, EWS_CB = 81 * EMiB, EWS_U = 97 * EMiB, EWS_Q = 113 * EMiB, EWS_K = 129 * EMiB, EWS_V = 145 * EMiB, EWS_G = 161 * EMiB, EWS_MG = 129 * EMiB;
enum { EP_SWIGLU = 0, EP_RESID = 1, EP_WIN = 2, EP_MERGE1 = 3, EP_MERGE2 = 4 };
struct EpiAll {
    static constexpr bool PERM = true, AFTER_DRAIN = false;
    int mode; float alpha;
    unsigned char* ws;
    float* outf;
    const float* base;
    const float* bgate;
    __device__ __forceinline__ void operator()(const f32x4 (&acc)[2][2][4][2], const Unit& u, int wr, int wc, int fr, int fq) const {
        const int row0 = u.pm * BM + wr * 64 + fr, lc = wc * 32 + 8 * fq, pn = u.pn;
        const float* ssq = (const float*)(ws + EWS_SSQ); float* ssq_out = (float*)(ws + EWS_SSQ);
        bf16_t* act = (bf16_t*)(ws + EWS_ACT); bf16_t* xb = (bf16_t*)(ws + EWS_XB);
        bf16_t* cb = (bf16_t*)(ws + EWS_CB); bf16_t* uu = (bf16_t*)(ws + EWS_U); bf16_t* q = (bf16_t*)(ws + EWS_Q); bf16_t* k = (bf16_t*)(ws + EWS_K); bf16_t* v = (bf16_t*)(ws + EWS_V);
        bf16_t* g = (bf16_t*)(ws + EWS_G); bf16_t* mg = (bf16_t*)(ws + EWS_MG);
        if (mode == EP_SWIGLU) {
#pragma unroll
            for (int ai = 0; ai < 2; ++ai)
#pragma unroll
                for (int m = 0; m < 4; ++m) { const int row = row0 + ai * HALF + m * 16; const float rs = rowscale(ssq, row);
                    f32x4 o[2];
#pragma unroll
                    for (int n = 0; n < 2; ++n) { const f32x4 a = acc[ai][0][m][n] * rs, b = acc[ai][1][m][n] * rs;
#pragma unroll
                        for (int e = 0; e < 4; ++e) o[n][e] = a[e] * sigmoid_f(a[e]) * b[e]; }
                    *(u32x4e*)(act + (size_t)row * 2816 + pn * 128 + lc) = pack8(o[0], o[1]); }
        } else if (mode == EP_RESID) {
#pragma unroll
            for (int ai = 0; ai < 2; ++ai)
#pragma unroll
                for (int m = 0; m < 4; ++m) { const int row = row0 + ai * HALF + m * 16; float s = 0.f;
#pragma unroll
                    for (int bj = 0; bj < 2; ++bj) { const size_t off = (size_t)row * 1024 + pn * BM + bj * HALF + lc;
                        const f32x4 x0 = *(const f32x4*)(base + off), x1 = *(const f32x4*)(base + off + 4);
                        const f32x4 y0 = x0 + acc[ai][bj][m][0] * alpha, y1 = x1 + acc[ai][bj][m][1] * alpha;
                        *(f32x4*)(outf + off) = y0; *(f32x4*)(outf + off + 4) = y1; *(u32x4e*)(xb + off) = pack8(y0, y1);
                        s += (y0[0] * y0[0] + y0[1] * y0[1]) + (y0[2] * y0[2] + y0[3] * y0[3]) + (y1[0] * y1[0] + y1[1] * y1[1]) + (y1[2] * y1[2] + y1[3] * y1[3]); }
                    s += __shfl_xor(s, 16); s += __shfl_xor(s, 32);
                    if (fq == 0) ssq_out[(size_t)row * 16 + pn * 4 + wc] = s; }
        } else if (mode == EP_WIN) {
#pragma unroll
            for (int ai = 0; ai < 2; ++ai)
#pragma unroll
                for (int m = 0; m < 4; ++m) { const int row = row0 + ai * HALF + m * 16; const float rs = rowscale(ssq, row);
                    if (pn >= 2 && pn < 6) {
                        const float rs2 = rs * rs;
                        const f32x4 o0 = acc[ai][0][m][0] * acc[ai][1][m][0] * rs2, o1 = acc[ai][0][m][1] * acc[ai][1][m][1] * rs2;
                        *(u32x4e*)(uu + (size_t)row * 512 + (pn - 2) * 128 + lc) = pack8(o0, o1);
                    } else {
#pragma unroll
                        for (int bj = 0; bj < 2; ++bj) { const int col = bj * HALF + lc;
                            if (pn < 2) { *(u32x4e*)(cb + (size_t)row * 512 + pn * BM + col) = pack8(acc[ai][bj][m][0] * rs, acc[ai][bj][m][1] * rs); }
                            else if (pn < 12) { const int t = (pn - 6) >> 1; bf16_t* dst = t == 0 ? q : (t == 1 ? k : v); const float sc = t == 0 ? rs * QSCALE : rs;
                                *(u32x4e*)(dst + (size_t)row * 512 + ((pn - 6) & 1) * BM + col) = pack8(acc[ai][bj][m][0] * sc, acc[ai][bj][m][1] * sc); }
                            else { const int gc = (pn - 12) * BM + col; const f32x4 b0 = *(const f32x4*)(bgate + gc), b1 = *(const f32x4*)(bgate + gc + 4);
                                const f32x4 z0 = acc[ai][bj][m][0] * rs + b0, z1 = acc[ai][bj][m][1] * rs + b1; f32x4 o0, o1;
#pragma unroll
                                for (int e = 0; e < 4; ++e) { o0[e] = sigmoid_f(z0[e]); o1[e] = sigmoid_f(z1[e]); }
                                *(u32x4e*)(g + (size_t)row * 2048 + gc) = pack8(o0, o1); } }
                    } }
        } else {
#pragma unroll
            for (int ai = 0; ai < 2; ++ai)
#pragma unroll
                for (int m = 0; m < 4; ++m) { const int row = row0 + ai * HALF + m * 16;
#pragma unroll
                    for (int bj = 0; bj < 2; ++bj) { const int col = pn * BM + bj * HALF + lc; bf16_t* ga = g + (size_t)row * 2048 + 1024 + col;
                        if (mode == EP_MERGE1) { f32x4 g0, g1; unpack8(*(const u32x4e*)ga, g0, g1); *(u32x4e*)ga = pack8(g0 * acc[ai][bj][m][0], g1 * acc[ai][bj][m][1]); }
                        else { f32x4 g0, g1, m0, m1; unpack8(*(const u32x4e*)(g + (size_t)row * 2048 + col), g0, g1); unpack8(*(const u32x4e*)ga, m0, m1);
                            *(u32x4e*)(mg + (size_t)row * 1024 + col) = pack8(m0 + g0 * acc[ai][bj][m][0], m1 + g1 * acc[ai][bj][m][1]); } } }
        }
    }
};
template <class Epi, class Sched, bool ALIGN_EPI = false, bool SP2 = false>
__device__ __forceinline__ void gemm_phase(PG8_LAS unsigned char* lds, const Gemm g, const Sched& S, const Epi& E) {
    const int tid = ltid(), wid = __builtin_amdgcn_readfirstlane(tid >> 6), lane = tid & 63, wr = wid >> 2, wc = wid & 3, fr = lane & 15, fq = lane >> 4;
    const int K = g.K, nt = K / BK;
    unsigned voffA[2], voffB[2];
#pragma unroll
    for (int i = 0; i < 2; ++i) { int R, C; stage_rc(tid * 16 + i * 8192, R, C); const int Rb = Epi::PERM ? ((R & ~31) + perm32(R & 31)) : R;
        voffA[i] = (unsigned)(R * K + C) * 2u; voffB[i] = (unsigned)(Rb * K + C) * 2u; }
    const size_t kstep = (size_t)(BK * 2);
    const size_t hstep = (size_t)HALF * K * 2;
    const size_t tstep = 2 * hstep;
    const unsigned ldsw = (unsigned)wid * 1024u;
    const int aoff = lds_byte(wr * 64 + fr, fq * 8), boff = lds_byte(wc * 32 + fr, fq * 8);
#define PG8_SA(b, h) (((b) * 2 + (h)) * HTB)
#define PG8_SB(b, h) ((4 + (b) * 2 + (h)) * HTB)
#define PG8_STAGE(bufoff, gbase, voff) do { _Pragma("unroll") for (int _i = 0; _i < 2; ++_i) \
        __builtin_amdgcn_global_load_lds((const unsigned*)((const char*)(gbase) + (voff)[_i]), (PG8_LAS unsigned*)(lds + (bufoff) + ldsw + _i * 8192), 16, 0, 0); } while (0)
#define PG8_LDA(dst, b, h) do { _Pragma("unroll") for (int m = 0; m < 4; ++m) _Pragma("unroll") for (int k = 0; k < 2; ++k) dst[m][k] = *(const PG8_LAS bf16x8*)(lds + PG8_SA(b, h) + aoff + m * 2048 + k * 1024); } while (0)
#define PG8_LDB(dst, b, h) do { _Pragma("unroll") for (int n = 0; n < 2; ++n) _Pragma("unroll") for (int k = 0; k < 2; ++k) dst[n][k] = *(const PG8_LAS bf16x8*)(lds + PG8_SB(b, h) + boff + n * 2048 + k * 1024); } while (0)
#define PG8_MMA(ai, bj, At, Bt) do { __builtin_amdgcn_s_setprio(1); _Pragma("unroll") for (int m = 0; m < 4; ++m) _Pragma("unroll") for (int n = 0; n < 2; ++n) _Pragma("unroll") for (int k = 0; k < 2; ++k) \
        acc[ai][bj][m][n] = __builtin_amdgcn_mfma_f32_16x16x32_bf16(Bt[n][k], At[m][k], acc[ai][bj][m][n], 0, 0, 0); __builtin_amdgcn_s_setprio(0); } while (0)
#define PG8_WAIT_V(n) asm volatile("s_waitcnt vmcnt(" #n ")" ::: "memory")
#define PG8_WAIT_L(n) asm volatile("s_waitcnt lgkmcnt(" #n ")" ::: "memory")
#define PG8_BAR __builtin_amdgcn_s_barrier()
#define PG8_SCHED __builtin_amdgcn_sched_barrier(0)
    Unit cur, nxt; int ui = 0;
    if (!S.next(0, cur)) return;
    f32x4 acc[2][2][4][2];
#pragma unroll
    for (int a = 0; a < 2; ++a)
#pragma unroll
        for (int b = 0; b < 2; ++b)
#pragma unroll
            for (int m = 0; m < 4; ++m)
#pragma unroll
                for (int n = 0; n < 2; ++n) acc[a][b][m][n] = (f32x4){0.f, 0.f, 0.f, 0.f};
    bf16x8 At[4][2], B0[2][2], B1[2][2];
    const char* cA = (const char*)g.A + (size_t)cur.pm * tstep; const char* cB = (const char*)g.Bt + (size_t)cur.pn * tstep;
    S.a_ready(cur);
    if constexpr (SP2) {
        PG8_STAGE(PG8_SB(0, 0), cB, voffB); PG8_STAGE(PG8_SB(0, 1), cB + hstep, voffB); PG8_STAGE(PG8_SA(0, 0), cA, voffA); PG8_STAGE(PG8_SA(0, 1), cA + hstep, voffA);
        if (wr == 1) PG8_BAR;
        PG8_WAIT_V(2); PG8_BAR;
        PG8_STAGE(PG8_SB(1, 0), cB + kstep, voffB); PG8_STAGE(PG8_SA(1, 0), cA + kstep, voffA); PG8_STAGE(PG8_SB(1, 1), cB + hstep + kstep, voffB);
        PG8_WAIT_V(6); PG8_BAR;
    } else {
        PG8_STAGE(PG8_SB(0, 0), cB, voffB); PG8_STAGE(PG8_SA(0, 0), cA, voffA); PG8_STAGE(PG8_SB(0, 1), cB + hstep, voffB); PG8_STAGE(PG8_SA(0, 1), cA + hstep, voffA);
        if (wr == 1) PG8_BAR;
        PG8_WAIT_V(4); PG8_BAR;
        PG8_STAGE(PG8_SB(1, 0), cB + kstep, voffB); PG8_STAGE(PG8_SA(1, 0), cA + kstep, voffA); PG8_STAGE(PG8_SB(1, 1), cB + hstep + kstep, voffB);
        PG8_WAIT_V(6); PG8_BAR;
    }
    for (;;) {
        const bool has_next = S.next(ui + 1, nxt);
        const char* nA = has_next ? (const char*)g.A + (size_t)nxt.pm * tstep : cA; const char* nB = has_next ? (const char*)g.Bt + (size_t)nxt.pn * tstep : cB;
        for (int t = 0; t < nt; t += 2) {
            const bool last = (t == nt - 2);
            const char* a1 = cA + (size_t)(t + 1) * kstep;
            const char* a2 = last ? nA : cA + (size_t)(t + 2) * kstep; const char* b2 = last ? nB : cB + (size_t)(t + 2) * kstep;
            const char* a3 = a2 + kstep; const char* b3 = b2 + kstep;
            if (last && has_next) S.a_ready(nxt);
            if constexpr (SP2) {
            PG8_LDB(B0, 0, 0); PG8_LDB(B1, 0, 1); PG8_SCHED; PG8_LDA(At, 0, 0); PG8_STAGE(PG8_SA(1, 1), a1 + hstep, voffA);
            PG8_WAIT_V(8); PG8_WAIT_L(0); PG8_BAR; PG8_MMA(0, 0, At, B0); PG8_MMA(0, 1, At, B1); PG8_BAR; PG8_SCHED;
            PG8_LDA(At, 0, 1); PG8_STAGE(PG8_SB(0, 0), b2, voffB); PG8_STAGE(PG8_SB(0, 1), b2 + hstep, voffB); PG8_STAGE(PG8_SA(0, 0), a2, voffA);
            PG8_WAIT_V(8); PG8_WAIT_L(0); PG8_BAR; PG8_MMA(1, 0, At, B0); PG8_MMA(1, 1, At, B1); PG8_BAR; PG8_SCHED;
            PG8_LDB(B0, 1, 0); PG8_LDB(B1, 1, 1); PG8_SCHED; PG8_LDA(At, 1, 0); PG8_STAGE(PG8_SA(0, 1), a2 + hstep, voffA);
            PG8_WAIT_V(8); PG8_WAIT_L(0); PG8_BAR; PG8_MMA(0, 0, At, B0); PG8_MMA(0, 1, At, B1); PG8_BAR; PG8_SCHED;
            PG8_LDA(At, 1, 1); PG8_STAGE(PG8_SB(1, 0), b3, voffB); PG8_STAGE(PG8_SB(1, 1), b3 + hstep, voffB); PG8_STAGE(PG8_SA(1, 0), a3, voffA);
            PG8_WAIT_V(8); PG8_WAIT_L(0); PG8_BAR; PG8_MMA(1, 0, At, B0); PG8_MMA(1, 1, At, B1); PG8_BAR; PG8_SCHED;
            } else {
            PG8_LDB(B0, 0, 0); PG8_SCHED; PG8_LDA(At, 0, 0); PG8_STAGE(PG8_SA(1, 1), a1 + hstep, voffA);
            PG8_WAIT_L(8); PG8_BAR; PG8_WAIT_L(0); PG8_MMA(0, 0, At, B0); PG8_BAR; PG8_SCHED;
            PG8_LDB(B1, 0, 1); PG8_STAGE(PG8_SB(0, 0), b2, voffB);
            PG8_BAR; PG8_WAIT_L(0); PG8_MMA(0, 1, At, B1); PG8_BAR;
            PG8_LDA(At, 0, 1); PG8_STAGE(PG8_SA(0, 0), a2, voffA);
            PG8_BAR; PG8_WAIT_L(0); PG8_MMA(1, 0, At, B0); PG8_BAR; PG8_SCHED;
            PG8_STAGE(PG8_SB(0, 1), b2 + hstep, voffB);
            PG8_WAIT_V(6); PG8_BAR; PG8_MMA(1, 1, At, B1); PG8_BAR;
            PG8_LDB(B0, 1, 0); PG8_SCHED; PG8_LDA(At, 1, 0); PG8_STAGE(PG8_SA(0, 1), a2 + hstep, voffA);
            PG8_WAIT_L(8); PG8_BAR; PG8_WAIT_L(0); PG8_MMA(0, 0, At, B0); PG8_BAR; PG8_SCHED;
            PG8_LDB(B1, 1, 1); PG8_STAGE(PG8_SB(1, 0), b3, voffB);
            PG8_BAR; PG8_WAIT_L(0); PG8_MMA(0, 1, At, B1); PG8_BAR;
            PG8_LDA(At, 1, 1); PG8_STAGE(PG8_SA(1, 0), a3, voffA);
            PG8_BAR; PG8_WAIT_L(0); PG8_MMA(1, 0, At, B0); PG8_BAR; PG8_SCHED;
            PG8_STAGE(PG8_SB(1, 1), b3 + hstep, voffB);
            PG8_WAIT_V(6); PG8_BAR; PG8_MMA(1, 1, At, B1); PG8_BAR;
            }
        }
        if constexpr (ALIGN_EPI) { if (wr == 0) PG8_BAR; }
        if constexpr (!Epi::AFTER_DRAIN) { E(acc, cur, wr, wc, fr, fq); S.done(cur); }
        if (!has_next) break;
#pragma unroll
        for (int a = 0; a < 2; ++a)
#pragma unroll
            for (int b = 0; b < 2; ++b)
#pragma unroll
                for (int m = 0; m < 4; ++m)
#pragma unroll
                    for (int n = 0; n < 2; ++n) acc[a][b][m][n] = (f32x4){0.f, 0.f, 0.f, 0.f};
        cur = nxt; cA = nA; cB = nB; ++ui;
        if constexpr (ALIGN_EPI) { if (wr == 1) PG8_BAR; }
    }
    PG8_WAIT_V(0);
    if constexpr (!ALIGN_EPI) { if (wr == 0) PG8_BAR; }
    PG8_BAR;
    if constexpr (Epi::AFTER_DRAIN) { E.fused(acc, cur, wr, wc, fr, fq, lds, wid, lane); S.done(cur); }
#undef PG8_SA
#undef PG8_SB
#undef PG8_STAGE
#undef PG8_LDA
#undef PG8_LDB
#undef PG8_MMA
#undef PG8_WAIT_V
#undef PG8_WAIT_L
#undef PG8_BAR
#undef PG8_SCHED
}
}
#define GAS __attribute__((address_space(1)))
#define LAS __attribute__((address_space(3)))
typedef unsigned short bf16;
typedef unsigned v4u __attribute__((ext_vector_type(4)));
typedef float f32x4 __attribute__((ext_vector_type(4)));
typedef short bf16x8 __attribute__((ext_vector_type(8)));
typedef GAS unsigned gu32;
typedef GAS unsigned long long gu64;
#define RLX_AGENT __ATOMIC_RELAXED, __HIP_MEMORY_SCOPE_AGENT
#define LDS_WAIT() asm volatile("s_waitcnt lgkmcnt(0)" ::: "memory")
#define VM_WAIT() asm volatile("s_waitcnt vmcnt(0)" ::: "memory")
__device__ __forceinline__ unsigned long long rt() { return __builtin_amdgcn_s_memrealtime(); }
__device__ __forceinline__ unsigned f2bf(float f) { unsigned u = __builtin_bit_cast(unsigned, f); return (u + 0x7fffu + ((u >> 16) & 1u)) >> 16; }
__device__ __forceinline__ unsigned pk2(float lo, float hi) { return f2bf(lo) | (f2bf(hi) << 16); }
#define XB_TMO      128
#define XB_XCNT(j)  (256  + 64 * (j))
#define XB_XSUB(j)  (1280 + 64 * (j))
#define XB_XGEN(j)  (2304 + 64 * (j))
#define XB_TOP      3328
#define XB_TOPGEN   3392
#define XCD_BAR_WORDS 3456
#define XB_SPIN_CAP (1u << 18)

__device__ __forceinline__ unsigned xb_ld(unsigned* p)              { return __hip_atomic_load(p, __ATOMIC_RELAXED, __HIP_MEMORY_SCOPE_AGENT); }
__device__ __forceinline__ unsigned xb_add(unsigned* p, unsigned v) { return __hip_atomic_fetch_add(p, v, __ATOMIC_RELAXED, __HIP_MEMORY_SCOPE_AGENT); }
__device__ __forceinline__ unsigned xb_xcc_id() { return (unsigned)__builtin_amdgcn_s_getreg((3 << 11) | 20) & 0xFu; }
#define XB_SPIN(cond, bar) do { unsigned _sp = 0; while (cond) { __builtin_amdgcn_s_sleep(1); \
    if ((++_sp & 255u) == 0u) { if (xb_ld(&(bar)[XB_TMO])) break; if (_sp > XB_SPIN_CAP) { atomicAdd(&(bar)[XB_TMO], 1u); break; } } } } while (0)

struct XcdBarrier {
    unsigned* bar; unsigned x;
    volatile LAS unsigned* st;
};

__device__ __forceinline__ XcdBarrier xcd_barrier_post(unsigned* bar, volatile LAS unsigned* st) {
    XcdBarrier b; b.bar = bar; b.x = xb_xcc_id(); b.st = st;
    if (threadIdx.x == 0) (void)xb_add(&bar[XB_XCNT(b.x)], 1u);
    return b;
}
__device__ __forceinline__ void xcd_barrier_complete(unsigned* bar, unsigned x, unsigned& nloc, unsigned& nx) {
    const unsigned G = gridDim.x * gridDim.y * gridDim.z;
    unsigned sum, cnt, mine, sp = 0u;
    for (;;) {
        sum = 0u; cnt = 0u; mine = 0u;
#pragma unroll
        for (unsigned j = 0; j < 16; ++j) { const unsigned c = xb_ld(&bar[XB_XCNT(j)]); sum += c; cnt += (c > 0u) ? 1u : 0u; mine = (j == x) ? c : mine; }
        if (sum == G) break;
        __builtin_amdgcn_s_sleep(1);
        if ((++sp & 255u) == 0u) { if (xb_ld(&bar[XB_TMO])) break; if (sp > XB_SPIN_CAP) { atomicAdd(&bar[XB_TMO], 1u); break; } }
    }
    nloc = mine > 0u ? mine : 1u; nx = cnt > 0u ? cnt : 1u;
}

__device__ __forceinline__ void xcd_barrier(const XcdBarrier& b) {
    asm volatile("s_waitcnt vmcnt(0)" ::: "memory");
    __syncthreads();
    if (threadIdx.x == 0) {
        unsigned* bar = b.bar;
        __builtin_amdgcn_s_waitcnt(0);
        unsigned nloc = b.st[0], nx = b.st[1];
        if (nloc == 0u) { xcd_barrier_complete(bar, b.x, nloc, nx); b.st[0] = nloc; b.st[1] = nx; }
        const unsigned old = xb_add(&bar[XB_XSUB(b.x)], 1u);
        const unsigned gen = old / nloc;
        if (old + 1u == (gen + 1u) * nloc) {
            __builtin_amdgcn_fence(__ATOMIC_RELEASE, "agent");
            asm volatile("s_waitcnt vmcnt(0)" ::: "memory");
            const unsigned og = xb_add(&bar[XB_TOP], 1u);
            const unsigned tg = og / nx;
            if (og + 1u == (tg + 1u) * nx) xb_add(&bar[XB_TOPGEN], 1u);
            else XB_SPIN(xb_ld(&bar[XB_TOPGEN]) == tg, bar);
            __builtin_amdgcn_fence(__ATOMIC_ACQUIRE, "agent");
            xb_add(&bar[XB_XGEN(b.x)], 1u);
            asm volatile("s_waitcnt vmcnt(0)" ::: "memory");
        } else {
            XB_SPIN(xb_ld(&bar[XB_XGEN(b.x)]) == gen, bar);
            __builtin_amdgcn_fence(__ATOMIC_ACQUIRE, "agent");
            asm volatile("s_waitcnt vmcnt(0)" ::: "memory");
        }
    }
    __syncthreads();
}

namespace sba {
#define LAS3 __attribute__((address_space(3)))
typedef short bf16x8 __attribute__((ext_vector_type(8)));
typedef short s16x4 __attribute__((ext_vector_type(4)));
typedef float f32x16 __attribute__((ext_vector_type(16)));
typedef unsigned u32x4 __attribute__((ext_vector_type(4)));
typedef short v4i16_t __attribute__((ext_vector_type(4)));
typedef unsigned short bf16;
constexpr int SEQ = 2048, PITCH = 512, HD = 64;
__host__ __device__ __forceinline__ constexpr int crow(int r, int hi) { return (r & 3) + 8 * (r >> 2) + 4 * hi; }
__device__ __forceinline__ unsigned cvtpk(float lo, float hi) { unsigned r; asm volatile("v_cvt_pk_bf16_f32 %0, %1, %2" : "=v"(r) : "v"(lo), "v"(hi)); return r; }
__device__ __forceinline__ s16x4 vtr(LAS3 const unsigned char* p) { return __builtin_bit_cast(s16x4, __builtin_amdgcn_ds_read_tr16_b64_v4i16((LAS3 v4i16_t*)p)); }

template <bool PARTIAL>
__device__ __forceinline__ void tile(f32x16 (&o)[2], float& carry, const bf16x8 (&qr)[4], LAS3 const unsigned char* Kslot, LAS3 const unsigned char* Vslot, int lim, int r32, int hi, int lane) {
    f32x16 p0 = {}, p1 = {};
    LAS3 const unsigned char* kb = Kslot + hi * 1024 + r32 * 16;
#pragma unroll
    for (int d0 = 0; d0 < 4; ++d0) {
        const bf16x8 b0 = *(LAS3 const bf16x8*)(kb + d0 * 2048), b1 = *(LAS3 const bf16x8*)(kb + d0 * 2048 + 512);
        p0 = __builtin_amdgcn_mfma_f32_32x32x16_bf16(b0, qr[d0], p0, 0, 0, 0);
        p1 = __builtin_amdgcn_mfma_f32_32x32x16_bf16(b1, qr[d0], p1, 0, 0, 0);
    }
    float kp[32], be[32];
#pragma unroll
    for (int i = 0; i < 32; ++i) {
        const float z = i < 16 ? p0[i] : p1[i - 16];
        const float t = __builtin_amdgcn_exp2f(-__builtin_fabsf(z));
        const float rr = __builtin_amdgcn_rcpf(1.0f + t), uu = t * rr;
        const bool pos = z >= 0.f;
        float b_ = pos ? rr : uu, k_ = pos ? uu : rr;
        if (PARTIAL) { const int c = crow(i & 15, 0) + (i >> 4) * 32; const bool valid = c < lim; b_ = valid ? b_ : 0.f; k_ = valid ? k_ : 1.f; }
        be[i] = b_; kp[i] = k_;
    }
    float E[16];
#pragma unroll
    for (int g = 0; g < 8; ++g) {
        const float gp = (kp[4 * g] * kp[4 * g + 1]) * (kp[4 * g + 2] * kp[4 * g + 3]);
        auto rr = __builtin_amdgcn_permlane32_swap(__float_as_uint(gp), __float_as_uint(gp), false, false);
        E[2 * g] = __uint_as_float(rr[0]); E[2 * g + 1] = __uint_as_float(rr[1]);
    }
    float SP[16]; SP[15] = carry;
#pragma unroll
    for (int k = 14; k >= 0; --k) SP[k] = SP[k + 1] * E[k + 1];
    carry = SP[0] * E[0];
    float a[32];
#pragma unroll
    for (int g = 0; g < 8; ++g) {
        float x = hi ? SP[2 * g + 1] : SP[2 * g];
        a[4 * g + 3] = be[4 * g + 3] * x; x *= kp[4 * g + 3];
        a[4 * g + 2] = be[4 * g + 2] * x; x *= kp[4 * g + 2];
        a[4 * g + 1] = be[4 * g + 1] * x; x *= kp[4 * g + 1];
        a[4 * g] = be[4 * g] * x;
    }
    u32x4 pw[4];
#pragma unroll
    for (int ks = 0; ks < 4; ++ks) { pw[ks].x = cvtpk(a[8 * ks], a[8 * ks + 1]); pw[ks].y = cvtpk(a[8 * ks + 2], a[8 * ks + 3]); pw[ks].z = cvtpk(a[8 * ks + 4], a[8 * ks + 5]); pw[ks].w = cvtpk(a[8 * ks + 6], a[8 * ks + 7]); }
    LAS3 const unsigned char* vb = Vslot + ((lane >> 4) & 1) * 32 + (lane & 3) * 8 + (4 * hi + ((lane & 15) >> 2)) * 64;
#pragma unroll
    for (int d0 = 0; d0 < 2; ++d0)
#pragma unroll
        for (int ks = 0; ks < 4; ++ks) {
            const s16x4 lo = vtr(vb + d0 * 4096 + ks * 1024), h4 = vtr(vb + d0 * 4096 + ks * 1024 + 512);
            const bf16x8 vf = (bf16x8){lo[0], lo[1], lo[2], lo[3], h4[0], h4[1], h4[2], h4[3]};
            o[d0] = __builtin_amdgcn_mfma_f32_32x32x16_bf16(__builtin_bit_cast(bf16x8, pw[ks]), vf, o[d0], 0, 0, 0);
        }
}

__device__ __forceinline__ void attn_unit(int b, int h, int qb, const bf16* Q, const bf16* K, const bf16* V, bf16* O, LAS3 unsigned char* lds) {
    const int tid = ltid(), lane = tid & 63, r32 = lane & 31, hi = lane >> 5; const int wid = __builtin_amdgcn_readfirstlane(tid >> 6);
    const size_t rowbase = (size_t)b * SEQ; const int q0 = qb * 256;
    const int myq = q0 + wid * 32 + r32;
    const bf16* Qw = Q + (rowbase + myq) * PITCH + h * HD;
    bf16x8 qr[4];
#pragma unroll
    for (int d0 = 0; d0 < 4; ++d0) qr[d0] = *(const bf16x8*)(Qw + d0 * 16 + hi * 8);
    const bf16* ksrc = K + (rowbase + lane) * PITCH + h * HD + wid * 8;
    const bf16* vsrc = V + (rowbase + 16 * (wid & 3) + (lane >> 2)) * PITCH + h * HD + (wid >> 2) * 32 + (lane & 3) * 8;
    const int stoff = wid * 1024 + lane * 16;
    const int NT = 4 * qb + 4;
    u32x4 kreg = *(const u32x4*)(ksrc + (size_t)(NT - 1) * 64 * PITCH), vreg = *(const u32x4*)(vsrc + (size_t)(NT - 1) * 64 * PITCH);
    *(LAS3 u32x4*)(lds + stoff) = kreg; *(LAS3 u32x4*)(lds + 16384 + stoff) = vreg;
    __syncthreads();
    f32x16 o[2]; o[0] = f32x16{}; o[1] = f32x16{};
    float carry = 1.f; int buf = 0;
    const int tmin = q0 + wid * 32, tmax = tmin + 31;
    for (int j = NT - 1; j >= 0; --j) {
        if (j > 0) { kreg = *(const u32x4*)(ksrc + (size_t)(j - 1) * 64 * PITCH); vreg = *(const u32x4*)(vsrc + (size_t)(j - 1) * 64 * PITCH); }
        if (64 * j < tmax) {
            const int lim = myq - 64 * j - 4 * hi;
            if (64 * j + 63 >= tmin) tile<true>(o, carry, qr, lds + buf * 8192, lds + 16384 + buf * 8192, lim, r32, hi, lane);
            else tile<false>(o, carry, qr, lds + buf * 8192, lds + 16384 + buf * 8192, lim, r32, hi, lane);
        }
        if (j > 0) { *(LAS3 u32x4*)(lds + (buf ^ 1) * 8192 + stoff) = kreg; *(LAS3 u32x4*)(lds + 16384 + (buf ^ 1) * 8192 + stoff) = vreg; }
        __syncthreads();
        buf ^= 1;
    }
    bf16* Ow = O + (rowbase + q0 + wid * 32) * PITCH + h * HD + r32;
#pragma unroll
    for (int r = 0; r < 16; ++r) { const int orow = crow(r, 0) + 4 * hi;
#pragma unroll
        for (int d0 = 0; d0 < 2; ++d0) Ow[(size_t)orow * PITCH + d0 * 32] = (bf16)(cvtpk(o[d0][r], 0.f) & 0xffffu); }
}
}

constexpr int NWAVES = 8;
constexpr int BATCH = 8, SEQ = 2048, D = 1024, DEPTH = 2, FF = 2816, NIN = 5120;
constexpr int M = BATCH * SEQ;
constexpr int N_PHASES = 9 * DEPTH + 1;
#ifndef MK_PER_PHASE
#define MK_PER_PHASE 0
#endif
constexpr size_t KiB = 1024, MiB = 1u << 20;
constexpr size_t WS_CTL = 0, CTL_ZERO_BYTES = 64 * KiB;
constexpr size_t WS_SSQ = 1 * MiB;
constexpr size_t WS_W13A = 2048 * KiB, WS_W2A = 13312 * KiB, WS_WIN = 18944 * KiB, WS_WC = 29184 * KiB, WS_WA = 30208 * KiB, WS_WO = 31232 * KiB, WS_W13B = 33280 * KiB, WS_W2B = 44544 * KiB;
constexpr size_t WS_XB = 49 * MiB;
constexpr size_t WS_ACT = 81 * MiB;
constexpr size_t WS_CB = 81 * MiB, WS_U = 97 * MiB, WS_Q = 113 * MiB, WS_K = 129 * MiB, WS_V = 145 * MiB, WS_G = 161 * MiB, WS_MG = 129 * MiB, WS_END = 225 * MiB;
static_assert(WS_SSQ == pg8::EWS_SSQ && WS_XB == pg8::EWS_XB && WS_ACT == pg8::EWS_ACT && WS_CB == pg8::EWS_CB && WS_U == pg8::EWS_U && WS_Q == pg8::EWS_Q && WS_K == pg8::EWS_K && WS_V == pg8::EWS_V && WS_G == pg8::EWS_G && WS_MG == pg8::EWS_MG, "d_ws map shared with the epilogue");
static_assert(WS_W2B + (size_t)D * FF * 2 <= WS_XB && WS_ACT + (size_t)M * FF * 2 <= 256 * MiB && WS_G + (size_t)M * 2048 * 2 <= WS_END, "d_ws map");
constexpr int CW_BAR = 4096;
constexpr int RING_BYTES = 131072, LDSCTL_OFF = RING_BYTES, MISC_OFF = LDSCTL_OFF + 320, LDS_BYTES = 147456;

__device__ __forceinline__ float wave_sum(float v) {
#pragma unroll
    for (int o = 1; o < 64; o <<= 1) v += __shfl_xor(v, o);
    return v;
}
__device__ __forceinline__ int maprow(int mode, int n) {
    if (mode == 1) { if (n < FF) return 256 * (n / 128) + (n % 128); const int j = n - FF; return 256 * (j / 128) + 128 + (j % 128); }
    if (mode == 2) { if (n < 512 || n >= 1536) return n; const int j = (n - 512) & 511, second = (n >= 1024) ? 128 : 0; return 512 + 256 * (j / 128) + second + (j % 128); }
    return n;
}
__device__ __forceinline__ void transpose_item(const float* W, int K, int N, bf16* WT, const float* gain, int mode, LAS float* scr, int item, int lane) {
    const int nblk = N / 32, kb = item / nblk, nb = item % nblk, k0 = 64 * kb, n0 = 32 * nb;
#pragma unroll 8
    for (int i = 0; i < 32; ++i) { const int kk = 2 * i + (lane >> 5); float w = W[(size_t)(k0 + kk) * N + n0 + (lane & 31)]; if (gain) w *= gain[k0 + kk]; scr[kk * 33 + (lane & 31)] = w; }
    LDS_WAIT(); asm volatile("" ::: "memory");
    const int c = lane & 7, nd0 = maprow(mode, n0);
#pragma unroll
    for (int j = 0; j < 4; ++j) { const int n = (lane >> 3) + 8 * j; const LAS float* s = scr + (8 * c) * 33 + n;
        v4u o; o.x = pk2(s[0 * 33], s[1 * 33]); o.y = pk2(s[2 * 33], s[3 * 33]); o.z = pk2(s[4 * 33], s[5 * 33]); o.w = pk2(s[6 * 33], s[7 * 33]);
        *(GAS v4u*)(WT + (size_t)(nd0 + n) * K + k0 + 8 * c) = o; }
    LDS_WAIT(); asm volatile("" ::: "memory");
}

struct Args { const float* in[15]; float* out; unsigned char* ws; int ph_lo, ph_hi, coop, pad; };

__global__ void __launch_bounds__(NWAVES * 64, 2) fwd_kernel(Args args_) {
    extern __shared__ __attribute__((aligned(16))) unsigned char lds[];
    {   LAS unsigned char* L0 = (LAS unsigned char*)lds;
        for (int u = threadIdx.x; u < (LDS_BYTES - LDSCTL_OFF) / 4; u += NWAVES * 64) ((LAS unsigned*)(L0 + LDSCTL_OFF))[u] = 0u;
        __syncthreads();
        if (args_.ph_hi - args_.ph_lo > 1) (void)xcd_barrier_post((unsigned*)(args_.ws + WS_CTL) + CW_BAR, (volatile LAS unsigned*)(L0 + MISC_OFF) + 8); }
    const int lo = args_.ph_lo, hi = args_.ph_hi;
    for (int ph = lo; ph < hi; ++ph) {
        const __attribute__((address_space(4))) Args* ap = (const __attribute__((address_space(4))) Args*)__builtin_amdgcn_kernarg_segment_ptr();
        asm volatile("" : "+s"(ap));
        const __attribute__((address_space(4))) Args& args = *ap;
        LAS unsigned char* L = (LAS unsigned char*)lds;
        const int tid = ltid(), lane = tid & 63, wave = __builtin_amdgcn_readfirstlane(tid >> 6);
        const int G = gridDim.x, bid = blockIdx.x;
        const int vcu = (G % 8 == 0) ? (bid % 8) * (G / 8) + bid / 8 : bid;
        unsigned char* ws = args.ws;
        const int gw = vcu * NWAVES + wave, NGW = G * NWAVES;
        const int l = ph / 9, s = ph % 9;
        if (ph == N_PHASES - 1) {
            const float* gfin = args.in[14]; float* const out = args.out;
            for (int m = gw; m < M; m += NGW) { GAS f32x4* xr = (GAS f32x4*)(out + (size_t)m * D) + lane; f32x4 v[4]; float sq = 0.f;
#pragma unroll
                for (int j = 0; j < 4; ++j) { v[j] = xr[64 * j]; sq += (v[j].x * v[j].x + v[j].y * v[j].y) + (v[j].z * v[j].z + v[j].w * v[j].w); }
                const float rs = 1.0f / sqrtf(wave_sum(sq) * (1.0f / D) + 1e-6f);
#pragma unroll
                for (int j = 0; j < 4; ++j) { const f32x4 gg = *((const f32x4*)gfin + 64 * j + lane); xr[64 * j] = v[j] * rs * gg; } }
        } else if (s == 0) {
            LAS float* scr = (LAS float*)(L + wave * 16384);
            const float* w13a = args.in[2] + (size_t)l * D * 2 * FF; const float* w2a = args.in[3] + (size_t)l * FF * D; const float* win = args.in[5] + (size_t)l * D * NIN;
            const float* wc = args.in[8] + (size_t)l * 512 * D; const float* wa = args.in[9] + (size_t)l * 512 * D; const float* wo = args.in[10] + (size_t)l * D * D;
            const float* w13b = args.in[12] + (size_t)l * D * 2 * FF; const float* w2b = args.in[13] + (size_t)l * FF * D;
            const float* g1 = args.in[1] + l * D; const float* gm = args.in[4] + l * D; const float* g2 = args.in[11] + l * D;
            constexpr int I13 = (D / 64) * (2 * FF / 32), I2 = (FF / 64) * (D / 32), IIN = (D / 64) * (NIN / 32), ICO = (512 / 64) * (D / 32), IO = (D / 64) * (D / 32);
            constexpr int NITEMS = 2 * I13 + 2 * I2 + IIN + 2 * ICO + IO;
            for (int it = gw; it < NITEMS; it += NGW) {
                int r = it;
                if (r < I13) { transpose_item(w13a, D, 2 * FF, (bf16*)(ws + WS_W13A), g1, 1, scr, r, lane); continue; } r -= I13;
                if (r < I13) { transpose_item(w13b, D, 2 * FF, (bf16*)(ws + WS_W13B), g2, 1, scr, r, lane); continue; } r -= I13;
                if (r < IIN) { transpose_item(win, D, NIN, (bf16*)(ws + WS_WIN), gm, 2, scr, r, lane); continue; } r -= IIN;
                if (r < I2) { transpose_item(w2a, FF, D, (bf16*)(ws + WS_W2A), nullptr, 0, scr, r, lane); continue; } r -= I2;
                if (r < I2) { transpose_item(w2b, FF, D, (bf16*)(ws + WS_W2B), nullptr, 0, scr, r, lane); continue; } r -= I2;
                if (r < IO) { transpose_item(wo, D, D, (bf16*)(ws + WS_WO), nullptr, 0, scr, r, lane); continue; } r -= IO;
                if (r < ICO) { transpose_item(wc, 512, D, (bf16*)(ws + WS_WC), nullptr, 0, scr, r, lane); continue; } r -= ICO;
                transpose_item(wa, 512, D, (bf16*)(ws + WS_WA), nullptr, 0, scr, r, lane);
            }
            if (l == 0) {
                const float* x = args.in[0]; bf16* const XB = (bf16*)(ws + WS_XB); float* const ssq = (float*)(ws + WS_SSQ);
                for (int m = gw; m < M; m += NGW) { const GAS f32x4* xr = (const GAS f32x4*)(x + (size_t)m * D) + lane; f32x4 v[4]; float sq = 0.f;
#pragma unroll
                    for (int j = 0; j < 4; ++j) { v[j] = xr[64 * j]; sq += (v[j].x * v[j].x + v[j].y * v[j].y) + (v[j].z * v[j].z + v[j].w * v[j].w); }
                    sq = wave_sum(sq);
                    GAS unsigned long long* o8 = (GAS unsigned long long*)(XB + (size_t)m * D) + lane;
#pragma unroll
                    for (int j = 0; j < 4; ++j) o8[64 * j] = (unsigned long long)pk2(v[j].x, v[j].y) | ((unsigned long long)pk2(v[j].z, v[j].w) << 32);
                    if (lane < 16) ssq[(size_t)m * 16 + lane] = lane == 0 ? sq : 0.f; }
            }
        } else if (s == 4) {
            const float* cw = args.in[7] + (size_t)l * 3 * 512;
            bf16* const CB = (bf16*)(ws + WS_CB); bf16* const U = (bf16*)(ws + WS_U); bf16* const Qb = (bf16*)(ws + WS_Q); bf16* const Kb = (bf16*)(ws + WS_K); bf16* const Vb = (bf16*)(ws + WS_V);
            for (int i = bid * (NWAVES * 64) + tid; i < M * 64; i += G * NWAVES * 64) { const int row = i >> 6, c0 = (i & 63) * 8, t = row & (SEQ - 1);
                const pg8::u32x4e zero4 = {0u, 0u, 0u, 0u};
                const pg8::u32x4e cbv = *(const pg8::u32x4e*)(CB + (size_t)row * 512 + c0), u2 = *(const pg8::u32x4e*)(U + (size_t)row * 512 + c0);
                const pg8::u32x4e u1 = t >= 1 ? *(const pg8::u32x4e*)(U + (size_t)(row - 1) * 512 + c0) : zero4, u0 = t >= 2 ? *(const pg8::u32x4e*)(U + (size_t)(row - 2) * 512 + c0) : zero4;
                f32x4 cb0, cb1, a0, a1, b0, b1, c0v, c1v; pg8::unpack8(cbv, cb0, cb1); pg8::unpack8(u0, a0, a1); pg8::unpack8(u1, b0, b1); pg8::unpack8(u2, c0v, c1v);
                const f32x4 w00 = *(const f32x4*)(cw + c0), w01 = *(const f32x4*)(cw + c0 + 4), w10 = *(const f32x4*)(cw + 512 + c0), w11 = *(const f32x4*)(cw + 512 + c0 + 4), w20 = *(const f32x4*)(cw + 1024 + c0), w21 = *(const f32x4*)(cw + 1024 + c0 + 4);
                const f32x4 y0 = cb0 * (w00 * a0 + w10 * b0 + w20 * c0v), y1 = cb1 * (w01 * a1 + w11 * b1 + w21 * c1v);
                *(pg8::u32x4e*)(CB + (size_t)row * 512 + c0) = pg8::pack8(y0, y1); }
            __syncthreads();
            for (int p = vcu; p < 256; p += G) { const int bh = p >> 2, sI = p & 3;
                sba::attn_unit(bh >> 3, bh & 7, 7 - sI, Qb, Kb, Vb, Qb, L);
                sba::attn_unit(bh >> 3, bh & 7, sI, Qb, Kb, Vb, Qb, L); }
        } else {
            const int ncall = (s == 5) ? 2 : 1;
            for (int c = 0; c < ncall; ++c) {
                pg8::Gemm g{}; pg8::EpiAll E{};
                E.ws = ws; E.outf = args.out; E.base = args.out; E.alpha = 0.5f; E.bgate = args.in[6] + (size_t)l * 2048;
                g.M = M;
                if (s == 1)      { g.A = (const bf16*)(ws + WS_XB);  g.Bt = (const bf16*)(ws + WS_W13A); g.N = 2 * FF; g.K = D;  E.mode = pg8::EP_SWIGLU; }
                else if (s == 2) { g.A = (const bf16*)(ws + WS_ACT); g.Bt = (const bf16*)(ws + WS_W2A);  g.N = D;      g.K = FF; E.mode = pg8::EP_RESID; if (l == 0) E.base = args.in[0]; }
                else if (s == 3) { g.A = (const bf16*)(ws + WS_XB);  g.Bt = (const bf16*)(ws + WS_WIN);  g.N = NIN;    g.K = D;  E.mode = pg8::EP_WIN; }
                else if (s == 5) { if (c == 0) { g.A = (const bf16*)(ws + WS_Q); g.Bt = (const bf16*)(ws + WS_WA); E.mode = pg8::EP_MERGE1; } else { g.A = (const bf16*)(ws + WS_CB); g.Bt = (const bf16*)(ws + WS_WC); E.mode = pg8::EP_MERGE2; } g.N = D; g.K = 512; }
                else if (s == 6) { g.A = (const bf16*)(ws + WS_MG);  g.Bt = (const bf16*)(ws + WS_WO);   g.N = D;      g.K = D;  E.mode = pg8::EP_RESID; E.alpha = 1.0f; }
                else if (s == 7) { g.A = (const bf16*)(ws + WS_XB);  g.Bt = (const bf16*)(ws + WS_W13B); g.N = 2 * FF; g.K = D;  E.mode = pg8::EP_SWIGLU; }
                else             { g.A = (const bf16*)(ws + WS_ACT); g.Bt = (const bf16*)(ws + WS_W2B);  g.N = D;      g.K = FF; E.mode = pg8::EP_RESID; }
                pg8::StaticOrder S; S.init(M, g.N, G, bid);
                pg8::gemm_phase<pg8::EpiAll, pg8::StaticOrder, true, true>(L, g, S, E);
            }
        }
        if (ph + 1 < hi) {
            if (ph == lo && args.coop) { __threadfence(); cg::this_grid().sync(); }
            else { XcdBarrier bar; bar.bar = (unsigned*)(ws + WS_CTL) + CW_BAR; bar.x = xb_xcc_id(); bar.st = (volatile LAS unsigned*)(L + MISC_OFF) + 8; xcd_barrier(bar); }
        }
    }
}

extern "C" void kernel_launch(void* const* d_in, const int* in_sizes, int n_in, void* d_out, int out_size, void* d_ws, size_t ws_size, hipStream_t stream) {
    static int grid = 0;
    if (grid == 0) {
        if (n_in != 15 || in_sizes[0] != M * D || out_size != M * D || ws_size < WS_END) { fprintf(stderr, "kernel_launch: unexpected shapes (n_in %d, in0 %d, out %d, ws %zu); nothing launched\n", n_in, n_in > 0 ? in_sizes[0] : -1, out_size, ws_size); grid = -1; return; }
        int dev = 0, cus = 0, per_cu = 0;
        if (hipGetDevice(&dev) != hipSuccess || hipDeviceGetAttribute(&cus, hipDeviceAttributeMultiprocessorCount, dev) != hipSuccess) { grid = -1; return; }
        if (hipFuncSetAttribute((const void*)fwd_kernel, hipFuncAttributeMaxDynamicSharedMemorySize, LDS_BYTES) != hipSuccess) { fprintf(stderr, "kernel_launch: hipFuncSetAttribute failed\n"); grid = -1; return; }
        if (hipOccupancyMaxActiveBlocksPerMultiprocessor(&per_cu, (const void*)fwd_kernel, NWAVES * 64, LDS_BYTES) != hipSuccess || per_cu < 1) { fprintf(stderr, "kernel_launch: occupancy query says %d blocks per CU; nothing launched\n", per_cu); (void)hipGetLastError(); grid = -1; return; }
        grid = cus < 256 ? cus : 256;
    }
    if (grid < 0) return;
    if (hipMemsetAsync((char*)d_ws + WS_CTL, 0, CTL_ZERO_BYTES, stream) != hipSuccess) { fprintf(stderr, "kernel_launch: hipMemsetAsync failed\n"); return; }
    Args a{};
    for (int i = 0; i < 15; ++i) a.in[i] = (const float*)d_in[i];
    a.out = (float*)d_out; a.ws = (unsigned char*)d_ws;
#if MK_PER_PHASE
    for (int ph = 0; ph < N_PHASES; ++ph) { a.ph_lo = ph; a.ph_hi = ph + 1; a.coop = 0;
        hipLaunchKernelGGL(fwd_kernel, dim3(grid), dim3(NWAVES * 64), LDS_BYTES, stream, a); }
#else
    a.ph_lo = 0; a.ph_hi = N_PHASES; a.coop = 1;
    void* kargs[] = {&a};
    const hipError_t e = hipLaunchCooperativeKernel((const void*)fwd_kernel, dim3(grid), dim3(NWAVES * 64), kargs, LDS_BYTES, stream);
    if (e != hipSuccess) fprintf(stderr, "kernel_launch: cooperative launch failed: %s (grid %d)\n", hipGetErrorString(e), grid);
#endif
}
```

```cpp
#include <hip/hip_runtime.h>
#include <hip/hip_cooperative_groups.h>
#include <cstdio>
#include <cstdint>
namespace cg = cooperative_groups;
__device__ __forceinline__ int ltid() { int t = threadIdx.x; asm volatile("" : "+v"(t)); return t; }
namespace pg8 {
#define PG8_LAS __attribute__((address_space(3)))
typedef unsigned short bf16_t;
typedef short bf16x8 __attribute__((ext_vector_type(8)));
typedef float f32x4 __attribute__((ext_vector_type(4)));
typedef unsigned u32x4 __attribute__((ext_vector_type(4)));
constexpr int BM = 256, BK = 64, HALF = 128, HTB = HALF * BK * 2  , STAGE_BYTES = 8 * HTB, NXCD = 8, WGM = 8;

__host__ __device__ __forceinline__ int lds_byte(int r, int c) { const int st = (r >> 4) * 2 + (c >> 5), rr = r & 15, cc = c & 31, ob = rr * 64 + cc * 2; return st * 1024 + (ob ^ (((ob >> 9) & 1) << 5)); }
__host__ __device__ __forceinline__ void stage_rc(int b, int& R, int& C) { const int st = b / 1024, sb = b % 1024, swz = sb ^ (((sb >> 9) & 1) << 5); R = (st >> 1) * 16 + swz / 64; C = (st & 1) * 32 + (swz % 64) / 2; }
__host__ __device__ __forceinline__ int perm32(int rho) { const int n = rho >> 4, i = rho & 15; return 8 * (i >> 2) + 4 * n + (i & 3); }

struct Unit { int pm, pn; };
struct Gemm { const bf16_t* A; const bf16_t* Bt; int M, N, K; };

struct StaticOrder {
    int nM, nN, nwg, G, c;
    __host__ __device__ void init(int M, int N, int G_, int c_) { nM = M / BM; nN = N / BM; nwg = nM * nN; G = G_; c = c_; }
    __host__ __device__ bool next(int i, Unit& u) const {
        const long L = (long)i * G + c; if (L >= nwg) return false;
        int wgid = (int)L; { const int q = nwg / NXCD, r = nwg % NXCD, xcd = wgid % NXCD, off = wgid / NXCD; wgid = (xcd < r ? xcd * (q + 1) : r * (q + 1) + (xcd - r) * q) + off; }
        const int nig = WGM * nN, gid = wgid / nig, fm = gid * WGM, gsz = (nM - fm) < WGM ? (nM - fm) : WGM;
        u.pm = fm + ((wgid % nig) % gsz); u.pn = (wgid % nig) / gsz; return true;
    }
    __device__ __forceinline__ void a_ready(const Unit&) const {}
    __device__ __forceinline__ void done(const Unit&) const {}
};

__device__ __forceinline__ unsigned cvt_pk_bf16(float lo, float hi) { unsigned r; asm volatile("v_cvt_pk_bf16_f32 %0, %1, %2" : "=v"(r) : "v"(lo), "v"(hi)); return r; }
typedef float f32x2 __attribute__((ext_vector_type(2)));

typedef unsigned u32x4e __attribute__((ext_vector_type(4)));
constexpr float LOG2E = 1.4426950408889634f;
constexpr float QSCALE = 0.125f * LOG2E;
__device__ __forceinline__ float rowscale(const float* ssq, int row) {
    const f32x4* p = (const f32x4*)(ssq + (size_t)row * 16);
    const f32x4 s = (p[0] + p[1]) + (p[2] + p[3]);
    return __builtin_amdgcn_rsqf(((s[0] + s[1]) + (s[2] + s[3])) * (1.0f / 1024.0f) + 1e-6f);
}
__device__ __forceinline__ float sigmoid_f(float x) { return __builtin_amdgcn_rcpf(1.0f + __builtin_amdgcn_exp2f(-x * LOG2E)); }
__device__ __forceinline__ u32x4e pack8(const f32x4 a, const f32x4 b) { u32x4e w; w.x = cvt_pk_bf16(a[0], a[1]); w.y = cvt_pk_bf16(a[2], a[3]); w.z = cvt_pk_bf16(b[0], b[1]); w.w = cvt_pk_bf16(b[2], b[3]); return w; }
__device__ __forceinline__ void unpack8(const u32x4e w, f32x4& a, f32x4& b) {
    a[0] = __uint_as_float(w.x << 16); a[1] = __uint_as_float(w.x & 0xffff0000u); a[2] = __uint_as_float(w.y << 16); a[3] = __uint_as_float(w.y & 0xffff0000u);
    b[0] = __uint_as_float(w.z << 16); b[1] = __uint_as_float(w.z & 0xffff0000u); b[2] = __uint_as_float(w.w << 16); b[3] = __uint_as_float(w.w & 0xffff0000u);
}
constexpr size_t EMiB = 1u << 20;
constexpr size_t EWS_SSQ = 1 * EMiB, EWS_XB = 49 * EMiB, EWS_ACT = 81 * EMiB, EWS_CB = 81 * EMiB, EWS_U = 97 * EMiB, EWS_Q = 113 * EMiB, EWS_K = 129 * EMiB, EWS_V = 145 * EMiB, EWS_G = 161 * EMiB, EWS_MG = 129 * EMiB;
enum { EP_SWIGLU = 0, EP_RESID = 1, EP_WIN = 2, EP_MERGE1 = 3, EP_MERGE2 = 4 };
struct EpiAll {
    static constexpr bool PERM = true, AFTER_DRAIN = false;
    int mode; float alpha;
    unsigned char* ws;
    float* outf;
    const float* base;
    const float* bgate;
    __device__ __forceinline__ void operator()(const f32x4 (&acc)[2][2][4][2], const Unit& u, int wr, int wc, int fr, int fq) const {
        const int row0 = u.pm * BM + wr * 64 + fr, lc = wc * 32 + 8 * fq, pn = u.pn;
        const float* ssq = (const float*)(ws + EWS_SSQ); float* ssq_out = (float*)(ws + EWS_SSQ);
        bf16_t* act = (bf16_t*)(ws + EWS_ACT); bf16_t* xb = (bf16_t*)(ws + EWS_XB);
        bf16_t* cb = (bf16_t*)(ws + EWS_CB); bf16_t* uu = (bf16_t*)(ws + EWS_U); bf16_t* q = (bf16_t*)(ws + EWS_Q); bf16_t* k = (bf16_t*)(ws + EWS_K); bf16_t* v = (bf16_t*)(ws + EWS_V);
        bf16_t* g = (bf16_t*)(ws + EWS_G); bf16_t* mg = (bf16_t*)(ws + EWS_MG);
        if (mode == EP_SWIGLU) {
#pragma unroll
            for (int ai = 0; ai < 2; ++ai)
#pragma unroll
                for (int m = 0; m < 4; ++m) { const int row = row0 + ai * HALF + m * 16; const float rs = rowscale(ssq, row);
                    f32x4 o[2];
#pragma unroll
                    for (int n = 0; n < 2; ++n) { const f32x4 a = acc[ai][0][m][n] * rs, b = acc[ai][1][m][n] * rs;
#pragma unroll
                        for (int e = 0; e < 4; ++e) o[n][e] = a[e] * sigmoid_f(a[e]) * b[e]; }
                    *(u32x4e*)(act + (size_t)row * 2816 + pn * 128 + lc) = pack8(o[0], o[1]); }
        } else if (mode == EP_RESID) {
#pragma unroll
            for (int ai = 0; ai < 2; ++ai)
#pragma unroll
                for (int m = 0; m < 4; ++m) { const int row = row0 + ai * HALF + m * 16; float s = 0.f;
#pragma unroll
                    for (int bj = 0; bj < 2; ++bj) { const size_t off = (size_t)row * 1024 + pn * BM + bj * HALF + lc;
                        const f32x4 x0 = *(const f32x4*)(base + off), x1 = *(const f32x4*)(base + off + 4);
                        const f32x4 y0 = x0 + acc[ai][bj][m][0] * alpha, y1 = x1 + acc[ai][bj][m][1] * alpha;
                        *(f32x4*)(outf + off) = y0; *(f32x4*)(outf + off + 4) = y1; *(u32x4e*)(xb + off) = pack8(y0, y1);
                        s += (y0[0] * y0[0] + y0[1] * y0[1]) + (y0[2] * y0[2] + y0[3] * y0[3]) + (y1[0] * y1[0] + y1[1] * y1[1]) + (y1[2] * y1[2] + y1[3] * y1[3]); }
                    s += __shfl_xor(s, 16); s += __shfl_xor(s, 32);
                    if (fq == 0) ssq_out[(size_t)row * 16 + pn * 4 + wc] = s; }
        } else if (mode == EP_WIN) {
#pragma unroll
            for (int ai = 0; ai < 2; ++ai)
#pragma unroll
                for (int m = 0; m < 4; ++m) { const int row = row0 + ai * HALF + m * 16; const float rs = rowscale(ssq, row);
                    if (pn >= 2 && pn < 6) {
                        const float rs2 = rs * rs;
                        const f32x4 o0 = acc[ai][0][m][0] * acc[ai][1][m][0] * rs2, o1 = acc[ai][0][m][1] * acc[ai][1][m][1] * rs2;
                        *(u32x4e*)(uu + (size_t)row * 512 + (pn - 2) * 128 + lc) = pack8(o0, o1);
                    } else {
#pragma unroll
                        for (int bj = 0; bj < 2; ++bj) { const int col = bj * HALF + lc;
                            if (pn < 2) { *(u32x4e*)(cb + (size_t)row * 512 + pn * BM + col) = pack8(acc[ai][bj][m][0] * rs, acc[ai][bj][m][1] * rs); }
                            else if (pn < 12) { const int t = (pn - 6) >> 1; bf16_t* dst = t == 0 ? q : (t == 1 ? k : v); const float sc = t == 0 ? rs * QSCALE : rs;
                                *(u32x4e*)(dst + (size_t)row * 512 + ((pn - 6) & 1) * BM + col) = pack8(acc[ai][bj][m][0] * sc, acc[ai][bj][m][1] * sc); }
                            else { const int gc = (pn - 12) * BM + col; const f32x4 b0 = *(const f32x4*)(bgate + gc), b1 = *(const f32x4*)(bgate + gc + 4);
                                const f32x4 z0 = acc[ai][bj][m][0] * rs + b0, z1 = acc[ai][bj][m][1] * rs + b1; f32x4 o0, o1;
#pragma unroll
                                for (int e = 0; e < 4; ++e) { o0[e] = sigmoid_f(z0[e]); o1[e] = sigmoid_f(z1[e]); }
                                *(u32x4e*)(g + (size_t)row * 2048 + gc) = pack8(o0, o1); } }
                    } }
        } else {
#pragma unroll
            for (int ai = 0; ai < 2; ++ai)
#pragma unroll
                for (int m = 0; m < 4; ++m) { const int row = row0 + ai * HALF + m * 16;
#pragma unroll
                    for (int bj = 0; bj < 2; ++bj) { const int col = pn * BM + bj * HALF + lc; bf16_t* ga = g + (size_t)row * 2048 + 1024 + col;
                        if (mode == EP_MERGE1) { f32x4 g0, g1; unpack8(*(const u32x4e*)ga, g0, g1); *(u32x4e*)ga = pack8(g0 * acc[ai][bj][m][0], g1 * acc[ai][bj][m][1]); }
                        else { f32x4 g0, g1, m0, m1; unpack8(*(const u32x4e*)(g + (size_t)row * 2048 + col), g0, g1); unpack8(*(const u32x4e*)ga, m0, m1);
                            *(u32x4e*)(mg + (size_t)row * 1024 + col) = pack8(m0 + g0 * acc[ai][bj][m][0], m1 + g1 * acc[ai][bj][m][1]); } } }
        }
    }
};
template <class Epi, class Sched, bool ALIGN_EPI = false, bool SP2 = false>
__device__ __forceinline__ void gemm_phase(PG8_LAS unsigned char* lds, const Gemm g, const Sched& S, const Epi& E) {
    const int tid = ltid(), wid = __builtin_amdgcn_readfirstlane(tid >> 6), lane = tid & 63, wr = wid >> 2, wc = wid & 3, fr = lane & 15, fq = lane >> 4;
    const int K = g.K, nt = K / BK;
    unsigned voffA[2], voffB[2];
#pragma unroll
    for (int i = 0; i < 2; ++i) { int R, C; stage_rc(tid * 16 + i * 8192, R, C); const int Rb = Epi::PERM ? ((R & ~31) + perm32(R & 31)) : R;
        voffA[i] = (unsigned)(R * K + C) * 2u; voffB[i] = (unsigned)(Rb * K + C) * 2u; }
    const size_t kstep = (size_t)(BK * 2);
    const size_t hstep = (size_t)HALF * K * 2;
    const size_t tstep = 2 * hstep;
    const unsigned ldsw = (unsigned)wid * 1024u;
    const int aoff = lds_byte(wr * 64 + fr, fq * 8), boff = lds_byte(wc * 32 + fr, fq * 8);
#define PG8_SA(b, h) (((b) * 2 + (h)) * HTB)
#define PG8_SB(b, h) ((4 + (b) * 2 + (h)) * HTB)
#define PG8_STAGE(bufoff, gbase, voff) do { _Pragma("unroll") for (int _i = 0; _i < 2; ++_i) \
        __builtin_amdgcn_global_load_lds((const unsigned*)((const char*)(gbase) + (voff)[_i]), (PG8_LAS unsigned*)(lds + (bufoff) + ldsw + _i * 8192), 16, 0, 0); } while (0)
#define PG8_LDA(dst, b, h) do { _Pragma("unroll") for (int m = 0; m < 4; ++m) _Pragma("unroll") for (int k = 0; k < 2; ++k) dst[m][k] = *(const PG8_LAS bf16x8*)(lds + PG8_SA(b, h) + aoff + m * 2048 + k * 1024); } while (0)
#define PG8_LDB(dst, b, h) do { _Pragma("unroll") for (int n = 0; n < 2; ++n) _Pragma("unroll") for (int k = 0; k < 2; ++k) dst[n][k] = *(const PG8_LAS bf16x8*)(lds + PG8_SB(b, h) + boff + n * 2048 + k * 1024); } while (0)
#define PG8_MMA(ai, bj, At, Bt) do { __builtin_amdgcn_s_setprio(1); _Pragma("unroll") for (int m = 0; m < 4; ++m) _Pragma("unroll") for (int n = 0; n < 2; ++n) _Pragma("unroll") for (int k = 0; k < 2; ++k) \
        acc[ai][bj][m][n] = __builtin_amdgcn_mfma_f32_16x16x32_bf16(Bt[n][k], At[m][k], acc[ai][bj][m][n], 0, 0, 0); __builtin_amdgcn_s_setprio(0); } while (0)
#define PG8_WAIT_V(n) asm volatile("s_waitcnt vmcnt(" #n ")" ::: "memory")
#define PG8_WAIT_L(n) asm volatile("s_waitcnt lgkmcnt(" #n ")" ::: "memory")
#define PG8_BAR __builtin_amdgcn_s_barrier()
#define PG8_SCHED __builtin_amdgcn_sched_barrier(0)
    Unit cur, nxt; int ui = 0;
    if (!S.next(0, cur)) return;
    f32x4 acc[2][2][4][2];
#pragma unroll
    for (int a = 0; a < 2; ++a)
#pragma unroll
        for (int b = 0; b < 2; ++b)
#pragma unroll
            for (int m = 0; m < 4; ++m)
#pragma unroll
                for (int n = 0; n < 2; ++n) acc[a][b][m][n] = (f32x4){0.f, 0.f, 0.f, 0.f};
    bf16x8 At[4][2], B0[2][2], B1[2][2];
    const char* cA = (const char*)g.A + (size_t)cur.pm * tstep; const char* cB = (const char*)g.Bt + (size_t)cur.pn * tstep;
    S.a_ready(cur);
    if constexpr (SP2) {
        PG8_STAGE(PG8_SB(0, 0), cB, voffB); PG8_STAGE(PG8_SB(0, 1), cB + hstep, voffB); PG8_STAGE(PG8_SA(0, 0), cA, voffA); PG8_STAGE(PG8_SA(0, 1), cA + hstep, voffA);
        if (wr == 1) PG8_BAR;
        PG8_WAIT_V(2); PG8_BAR;
        PG8_STAGE(PG8_SB(1, 0), cB + kstep, voffB); PG8_STAGE(PG8_SA(1, 0), cA + kstep, voffA); PG8_STAGE(PG8_SB(1, 1), cB + hstep + kstep, voffB);
        PG8_WAIT_V(6); PG8_BAR;
    } else {
        PG8_STAGE(PG8_SB(0, 0), cB, voffB); PG8_STAGE(PG8_SA(0, 0), cA, voffA); PG8_STAGE(PG8_SB(0, 1), cB + hstep, voffB); PG8_STAGE(PG8_SA(0, 1), cA + hstep, voffA);
        if (wr == 1) PG8_BAR;
        PG8_WAIT_V(4); PG8_BAR;
        PG8_STAGE(PG8_SB(1, 0), cB + kstep, voffB); PG8_STAGE(PG8_SA(1, 0), cA + kstep, voffA); PG8_STAGE(PG8_SB(1, 1), cB + hstep + kstep, voffB);
        PG8_WAIT_V(6); PG8_BAR;
    }
    for (;;) {
        const bool has_next = S.next(ui + 1, nxt);
        const char* nA = has_next ? (const char*)g.A + (size_t)nxt.pm * tstep : cA; const char* nB = has_next ? (const char*)g.Bt + (size_t)nxt.pn * tstep : cB;
        for (int t = 0; t < nt; t += 2) {
            const bool last = (t == nt - 2);
            const char* a1 = cA + (size_t)(t + 1) * kstep;
            const char* a2 = last ? nA : cA + (size_t)(t + 2) * kstep; const char* b2 = last ? nB : cB + (size_t)(t + 2) * kstep;
            const char* a3 = a2 + kstep; const char* b3 = b2 + kstep;
            if (last && has_next) S.a_ready(nxt);
            if constexpr (SP2) {
            PG8_LDB(B0, 0, 0); PG8_LDB(B1, 0, 1); PG8_SCHED; PG8_LDA(At, 0, 0); PG8_STAGE(PG8_SA(1, 1), a1 + hstep, voffA);
            PG8_WAIT_V(8); PG8_WAIT_L(0); PG8_BAR; PG8_MMA(0, 0, At, B0); PG8_MMA(0, 1, At, B1); PG8_BAR; PG8_SCHED;
            PG8_LDA(At, 0, 1); PG8_STAGE(PG8_SB(0, 0), b2, voffB); PG8_STAGE(PG8_SB(0, 1), b2 + hstep, voffB); PG8_STAGE(PG8_SA(0, 0), a2, voffA);
            PG8_WAIT_V(8); PG8_WAIT_L(0); PG8_BAR; PG8_MMA(1, 0, At, B0); PG8_MMA(1, 1, At, B1); PG8_BAR; PG8_SCHED;
            PG8_LDB(B0, 1, 0); PG8_LDB(B1, 1, 1); PG8_SCHED; PG8_LDA(At, 1, 0); PG8_STAGE(PG8_SA(0, 1), a2 + hstep, voffA);
            PG8_WAIT_V(8); PG8_WAIT_L(0); PG8_BAR; PG8_MMA(0, 0, At, B0); PG8_MMA(0, 1, At, B1); PG8_BAR; PG8_SCHED;
            PG8_LDA(At, 1, 1); PG8_STAGE(PG8_SB(1, 0), b3, voffB); PG8_STAGE(PG8_SB(1, 1), b3 + hstep, voffB); PG8_STAGE(PG8_SA(1, 0), a3, voffA);
            PG8_WAIT_V(8); PG8_WAIT_L(0); PG8_BAR; PG8_MMA(1, 0, At, B0); PG8_MMA(1, 1, At, B1); PG8_BAR; PG8_SCHED;
            } else {
            PG8_LDB(B0, 0, 0); PG8_SCHED; PG8_LDA(At, 0, 0); PG8_STAGE(PG8_SA(1, 1), a1 + hstep, voffA);
            PG8_WAIT_L(8); PG8_BAR; PG8_WAIT_L(0); PG8_MMA(0, 0, At, B0); PG8_BAR; PG8_SCHED;
            PG8_LDB(B1, 0, 1); PG8_STAGE(PG8_SB(0, 0), b2, voffB);
            PG8_BAR; PG8_WAIT_L(0); PG8_MMA(0, 1, At, B1); PG8_BAR;
            PG8_LDA(At, 0, 1); PG8_STAGE(PG8_SA(0, 0), a2, voffA);
            PG8_BAR; PG8_WAIT_L(0); PG8_MMA(1, 0, At, B0); PG8_BAR; PG8_SCHED;
            PG8_STAGE(PG8_SB(0, 1), b2 + hstep, voffB);
            PG8_WAIT_V(6); PG8_BAR; PG8_MMA(1, 1, At, B1); PG8_BAR;
            PG8_LDB(B0, 1, 0); PG8_SCHED; PG8_LDA(At, 1, 0); PG8_STAGE(PG8_SA(0, 1), a2 + hstep, voffA);
            PG8_WAIT_L(8); PG8_BAR; PG8_WAIT_L(0); PG8_MMA(0, 0, At, B0); PG8_BAR; PG8_SCHED;
            PG8_LDB(B1, 1, 1); PG8_STAGE(PG8_SB(1, 0), b3, voffB);
            PG8_BAR; PG8_WAIT_L(0); PG8_MMA(0, 1, At, B1); PG8_BAR;
            PG8_LDA(At, 1, 1); PG8_STAGE(PG8_SA(1, 0), a3, voffA);
            PG8_BAR; PG8_WAIT_L(0); PG8_MMA(1, 0, At, B0); PG8_BAR; PG8_SCHED;
            PG8_STAGE(PG8_SB(1, 1), b3 + hstep, voffB);
            PG8_WAIT_V(6); PG8_BAR; PG8_MMA(1, 1, At, B1); PG8_BAR;
            }
        }
        if constexpr (ALIGN_EPI) { if (wr == 0) PG8_BAR; }
        if constexpr (!Epi::AFTER_DRAIN) { E(acc, cur, wr, wc, fr, fq); S.done(cur); }
        if (!has_next) break;
#pragma unroll
        for (int a = 0; a < 2; ++a)
#pragma unroll
            for (int b = 0; b < 2; ++b)
#pragma unroll
                for (int m = 0; m < 4; ++m)
#pragma unroll
                    for (int n = 0; n < 2; ++n) acc[a][b][m][n] = (f32x4){0.f, 0.f, 0.f, 0.f};
        cur = nxt; cA = nA; cB = nB; ++ui;
        if constexpr (ALIGN_EPI) { if (wr == 1) PG8_BAR; }
    }
    PG8_WAIT_V(0);
    if constexpr (!ALIGN_EPI) { if (wr == 0) PG8_BAR; }
    PG8_BAR;
    if constexpr (Epi::AFTER_DRAIN) { E.fused(acc, cur, wr, wc, fr, fq, lds, wid, lane); S.done(cur); }
#undef PG8_SA
#undef PG8_SB
#undef PG8_STAGE
#undef PG8_LDA
#undef PG8_LDB
#undef PG8_MMA
#undef PG8_WAIT_V
#undef PG8_WAIT_L
#undef PG8_BAR
#undef PG8_SCHED
}
}
#define GAS __attribute__((address_space(1)))
#define LAS __attribute__((address_space(3)))
typedef unsigned short bf16;
typedef unsigned v4u __attribute__((ext_vector_type(4)));
typedef float f32x4 __attribute__((ext_vector_type(4)));
typedef short bf16x8 __attribute__((ext_vector_type(8)));
typedef GAS unsigned gu32;
typedef GAS unsigned long long gu64;
#define RLX_AGENT __ATOMIC_RELAXED, __HIP_MEMORY_SCOPE_AGENT
#define LDS_WAIT() asm volatile("s_waitcnt lgkmcnt(0)" ::: "memory")
#define VM_WAIT() asm volatile("s_waitcnt vmcnt(0)" ::: "memory")
__device__ __forceinline__ unsigned long long rt() { return __builtin_amdgcn_s_memrealtime(); }
__device__ __forceinline__ unsigned f2bf(float f) { unsigned u = __builtin_bit_cast(unsigned, f); return (u + 0x7fffu + ((u >> 16) & 1u)) >> 16; }
__device__ __forceinline__ unsigned pk2(float lo, float hi) { return f2bf(lo) | (f2bf(hi) << 16); }
#define XB_TMO      128
#define XB_XCNT(j)  (256  + 64 * (j))
#define XB_XSUB(j)  (1280 + 64 * (j))
#define XB_XGEN(j)  (2304 + 64 * (j))
#define XB_TOP      3328
#define XB_TOPGEN   3392
#define XCD_BAR_WORDS 3456
#define XB_SPIN_CAP (1u << 18)

__device__ __forceinline__ unsigned xb_ld(unsigned* p)              { return __hip_atomic_load(p, __ATOMIC_RELAXED, __HIP_MEMORY_SCOPE_AGENT); }
__device__ __forceinline__ unsigned xb_add(unsigned* p, unsigned v) { return __hip_atomic_fetch_add(p, v, __ATOMIC_RELAXED, __HIP_MEMORY_SCOPE_AGENT); }
__device__ __forceinline__ unsigned xb_xcc_id() { return (unsigned)__builtin_amdgcn_s_getreg((3 << 11) | 20) & 0xFu; }
#define XB_SPIN(cond, bar) do { unsigned _sp = 0; while (cond) { __builtin_amdgcn_s_sleep(1); \
    if ((++_sp & 255u) == 0u) { if (xb_ld(&(bar)[XB_TMO])) break; if (_sp > XB_SPIN_CAP) { atomicAdd(&(bar)[XB_TMO], 1u); break; } } } } while (0)

struct XcdBarrier {
    unsigned* bar; unsigned x;
    volatile LAS unsigned* st;
};

__device__ __forceinline__ XcdBarrier xcd_barrier_post(unsigned* bar, volatile LAS unsigned* st) {
    XcdBarrier b; b.bar = bar; b.x = xb_xcc_id(); b.st = st;
    if (threadIdx.x == 0) (void)xb_add(&bar[XB_XCNT(b.x)], 1u);
    return b;
}
__device__ __forceinline__ void xcd_barrier_complete(unsigned* bar, unsigned x, unsigned& nloc, unsigned& nx) {
    const unsigned G = gridDim.x * gridDim.y * gridDim.z;
    unsigned sum, cnt, mine, sp = 0u;
    for (;;) {
        sum = 0u; cnt = 0u; mine = 0u;
#pragma unroll
        for (unsigned j = 0; j < 16; ++j) { const unsigned c = xb_ld(&bar[XB_XCNT(j)]); sum += c; cnt += (c > 0u) ? 1u : 0u; mine = (j == x) ? c : mine; }
        if (sum == G) break;
        __builtin_amdgcn_s_sleep(1);
        if ((++sp & 255u) == 0u) { if (xb_ld(&bar[XB_TMO])) break; if (sp > XB_SPIN_CAP) { atomicAdd(&bar[XB_TMO], 1u); break; } }
    }
    nloc = mine > 0u ? mine : 1u; nx = cnt > 0u ? cnt : 1u;
}

__device__ __forceinline__ void xcd_barrier(const XcdBarrier& b) {
    asm volatile("s_waitcnt vmcnt(0)" ::: "memory");
    __syncthreads();
    if (threadIdx.x == 0) {
        unsigned* bar = b.bar;
        __builtin_amdgcn_s_waitcnt(0);
        unsigned nloc = b.st[0], nx = b.st[1];
        if (nloc == 0u) { xcd_barrier_complete(bar, b.x, nloc, nx); b.st[0] = nloc; b.st[1] = nx; }
        const unsigned old = xb_add(&bar[XB_XSUB(b.x)], 1u);
        const unsigned gen = old / nloc;
        if (old + 1u == (gen + 1u) * nloc) {
            __builtin_amdgcn_fence(__ATOMIC_RELEASE, "agent");
            asm volatile("s_waitcnt vmcnt(0)" ::: "memory");
            const unsigned og = xb_add(&bar[XB_TOP], 1u);
            const unsigned tg = og / nx;
            if (og + 1u == (tg + 1u) * nx) xb_add(&bar[XB_TOPGEN], 1u);
            else XB_SPIN(xb_ld(&bar[XB_TOPGEN]) == tg, bar);
            __builtin_amdgcn_fence(__ATOMIC_ACQUIRE, "agent");
            xb_add(&bar[XB_XGEN(b.x)], 1u);
            asm volatile("s_waitcnt vmcnt(0)" ::: "memory");
        } else {
            XB_SPIN(xb_ld(&bar[XB_XGEN(b.x)]) == gen, bar);
            __builtin_amdgcn_fence(__ATOMIC_ACQUIRE, "agent");
            asm volatile("s_waitcnt vmcnt(0)" ::: "memory");
        }
    }
    __syncthreads();
}

namespace sba {
#define LAS3 __attribute__((address_space(3)))
typedef short bf16x8 __attribute__((ext_vector_type(8)));
typedef short s16x4 __attribute__((ext_vector_type(4)));
typedef float f32x16 __attribute__((ext_vector_type(16)));
typedef unsigned u32x4 __attribute__((ext_vector_type(4)));
typedef short v4i16_t __attribute__((ext_vector_type(4)));
typedef unsigned short bf16;
constexpr int SEQ = 2048, PITCH = 512, HD = 64;
__host__ __device__ __forceinline__ constexpr int crow(int r, int hi) { return (r & 3) + 8 * (r >> 2) + 4 * hi; }
__device__ __forceinline__ unsigned cvtpk(float lo, float hi) { unsigned r; asm volatile("v_cvt_pk_bf16_f32 %0, %1, %2" : "=v"(r) : "v"(lo), "v"(hi)); return r; }
__device__ __forceinline__ s16x4 vtr(LAS3 const unsigned char* p) { return __builtin_bit_cast(s16x4, __builtin_amdgcn_ds_read_tr16_b64_v4i16((LAS3 v4i16_t*)p)); }

template <bool PARTIAL>
__device__ __forceinline__ void tile(f32x16 (&o)[2], float& carry, const bf16x8 (&qr)[4], LAS3 const unsigned char* Kslot, LAS3 const unsigned char* Vslot, int lim, int r32, int hi, int lane) {
    f32x16 p0 = {}, p1 = {};
    LAS3 const unsigned char* kb = Kslot + hi * 1024 + r32 * 16;
#pragma unroll
    for (int d0 = 0; d0 < 4; ++d0) {
        const bf16x8 b0 = *(LAS3 const bf16x8*)(kb + d0 * 2048), b1 = *(LAS3 const bf16x8*)(kb + d0 * 2048 + 512);
        p0 = __builtin_amdgcn_mfma_f32_32x32x16_bf16(b0, qr[d0], p0, 0, 0, 0);
        p1 = __builtin_amdgcn_mfma_f32_32x32x16_bf16(b1, qr[d0], p1, 0, 0, 0);
    }
    float kp[32], be[32];
#pragma unroll
    for (int i = 0; i < 32; ++i) {
        const float z = i < 16 ? p0[i] : p1[i - 16];
        const float t = __builtin_amdgcn_exp2f(-__builtin_fabsf(z));
        const float rr = __builtin_amdgcn_rcpf(1.0f + t), uu = t * rr;
        const bool pos = z >= 0.f;
        float b_ = pos ? rr : uu, k_ = pos ? uu : rr;
        if (PARTIAL) { const int c = crow(i & 15, 0) + (i >> 4) * 32; const bool valid = c < lim; b_ = valid ? b_ : 0.f; k_ = valid ? k_ : 1.f; }
        be[i] = b_; kp[i] = k_;
    }
    float E[16];
#pragma unroll
    for (int g = 0; g < 8; ++g) {
        const float gp = (kp[4 * g] * kp[4 * g + 1]) * (kp[4 * g + 2] * kp[4 * g + 3]);
        auto rr = __builtin_amdgcn_permlane32_swap(__float_as_uint(gp), __float_as_uint(gp), false, false);
        E[2 * g] = __uint_as_float(rr[0]); E[2 * g + 1] = __uint_as_float(rr[1]);
    }
    float SP[16]; SP[15] = carry;
#pragma unroll
    for (int k = 14; k >= 0; --k) SP[k] = SP[k + 1] * E[k + 1];
    carry = SP[0] * E[0];
    float a[32];
#pragma unroll
    for (int g = 0; g < 8; ++g) {
        float x = hi ? SP[2 * g + 1] : SP[2 * g];
        a[4 * g + 3] = be[4 * g + 3] * x; x *= kp[4 * g + 3];
        a[4 * g + 2] = be[4 * g + 2] * x; x *= kp[4 * g + 2];
        a[4 * g + 1] = be[4 * g + 1] * x; x *= kp[4 * g + 1];
        a[4 * g] = be[4 * g] * x;
    }
    u32x4 pw[4];
#pragma unroll
    for (int ks = 0; ks < 4; ++ks) { pw[ks].x = cvtpk(a[8 * ks], a[8 * ks + 1]); pw[ks].y = cvtpk(a[8 * ks + 2], a[8 * ks + 3]); pw[ks].z = cvtpk(a[8 * ks + 4], a[8 * ks + 5]); pw[ks].w = cvtpk(a[8 * ks + 6], a[8 * ks + 7]); }
    LAS3 const unsigned char* vb = Vslot + ((lane >> 4) & 1) * 32 + (lane & 3) * 8 + (4 * hi + ((lane & 15) >> 2)) * 64;
#pragma unroll
    for (int d0 = 0; d0 < 2; ++d0)
#pragma unroll
        for (int ks = 0; ks < 4; ++ks) {
            const s16x4 lo = vtr(vb + d0 * 4096 + ks * 1024), h4 = vtr(vb + d0 * 4096 + ks * 1024 + 512);
            const bf16x8 vf = (bf16x8){lo[0], lo[1], lo[2], lo[3], h4[0], h4[1], h4[2], h4[3]};
            o[d0] = __builtin_amdgcn_mfma_f32_32x32x16_bf16(__builtin_bit_cast(bf16x8, pw[ks]), vf, o[d0], 0, 0, 0);
        }
}

__device__ __forceinline__ void attn_unit(int b, int h, int qb, const bf16* Q, const bf16* K, const bf16* V, bf16* O, LAS3 unsigned char* lds) {
    const int tid = ltid(), lane = tid & 63, r32 = lane & 31, hi = lane >> 5; const int wid = __builtin_amdgcn_readfirstlane(tid >> 6);
    const size_t rowbase = (size_t)b * SEQ; const int q0 = qb * 256;
    const int myq = q0 + wid * 32 + r32;
    const bf16* Qw = Q + (rowbase + myq) * PITCH + h * HD;
    bf16x8 qr[4];
#pragma unroll
    for (int d0 = 0; d0 < 4; ++d0) qr[d0] = *(const bf16x8*)(Qw + d0 * 16 + hi * 8);
    const bf16* ksrc = K + (rowbase + lane) * PITCH + h * HD + wid * 8;
    const bf16* vsrc = V + (rowbase + 16 * (wid & 3) + (lane >> 2)) * PITCH + h * HD + (wid >> 2) * 32 + (lane & 3) * 8;
    const int stoff = wid * 1024 + lane * 16;
    const int NT = 4 * qb + 4;
    u32x4 kreg = *(const u32x4*)(ksrc + (size_t)(NT - 1) * 64 * PITCH), vreg = *(const u32x4*)(vsrc + (size_t)(NT - 1) * 64 * PITCH);
    *(LAS3 u32x4*)(lds + stoff) = kreg; *(LAS3 u32x4*)(lds + 16384 + stoff) = vreg;
    __syncthreads();
    f32x16 o[2]; o[0] = f32x16{}; o[1] = f32x16{};
    float carry = 1.f; int buf = 0;
    const int tmin = q0 + wid * 32, tmax = tmin + 31;
    for (int j = NT - 1; j >= 0; --j) {
        if (j > 0) { kreg = *(const u32x4*)(ksrc + (size_t)(j - 1) * 64 * PITCH); vreg = *(const u32x4*)(vsrc + (size_t)(j - 1) * 64 * PITCH); }
        if (64 * j < tmax) {
            const int lim = myq - 64 * j - 4 * hi;
            if (64 * j + 63 >= tmin) tile<true>(o, carry, qr, lds + buf * 8192, lds + 16384 + buf * 8192, lim, r32, hi, lane);
            else tile<false>(o, carry, qr, lds + buf * 8192, lds + 16384 + buf * 8192, lim, r32, hi, lane);
        }
        if (j > 0) { *(LAS3 u32x4*)(lds + (buf ^ 1) * 8192 + stoff) = kreg; *(LAS3 u32x4*)(lds + 16384 + (buf ^ 1) * 8192 + stoff) = vreg; }
        __syncthreads();
        buf ^= 1;
    }
    bf16* Ow = O + (rowbase + q0 + wid * 32) * PITCH + h * HD + r32;
#pragma unroll
    for (int r = 0; r < 16; ++r) { const int orow = crow(r, 0) + 4 * hi;
#pragma unroll
        for (int d0 = 0; d0 < 2; ++d0) Ow[(size_t)orow * PITCH + d0 * 32] = (bf16)(cvtpk(o[d0][r], 0.f) & 0xffffu); }
}
}

constexpr int NWAVES = 8;
constexpr int BATCH = 8, SEQ = 2048, D = 1024, DEPTH = 2, FF = 2816, NIN = 5120;
constexpr int M = BATCH * SEQ;
constexpr int N_PHASES = 9 * DEPTH + 1;
#ifndef MK_PER_PHASE
#define MK_PER_PHASE 0
#endif
constexpr size_t KiB = 1024, MiB = 1u << 20;
constexpr size_t WS_CTL = 0, CTL_ZERO_BYTES = 64 * KiB;
constexpr size_t WS_SSQ = 1 * MiB;
constexpr size_t WS_W13A = 2048 * KiB, WS_W2A = 13312 * KiB, WS_WIN = 18944 * KiB, WS_WC = 29184 * KiB, WS_WA = 30208 * KiB, WS_WO = 31232 * KiB, WS_W13B = 33280 * KiB, WS_W2B = 44544 * KiB;
constexpr size_t WS_XB = 49 * MiB;
constexpr size_t WS_ACT = 81 * MiB;
constexpr size_t WS_CB = 81 * MiB, WS_U = 97 * MiB, WS_Q = 113 * MiB, WS_K = 129 * MiB, WS_V = 145 * MiB, WS_G = 161 * MiB, WS_MG = 129 * MiB, WS_YA = 225 * MiB, WS_END = 241 * MiB;
static_assert(WS_SSQ == pg8::EWS_SSQ && WS_XB == pg8::EWS_XB && WS_ACT == pg8::EWS_ACT && WS_CB == pg8::EWS_CB && WS_U == pg8::EWS_U && WS_Q == pg8::EWS_Q && WS_K == pg8::EWS_K && WS_V == pg8::EWS_V && WS_G == pg8::EWS_G && WS_MG == pg8::EWS_MG, "d_ws map shared with the epilogue");
static_assert(WS_W2B + (size_t)D * FF * 2 <= WS_XB && WS_ACT + (size_t)M * FF * 2 <= 256 * MiB && WS_G + (size_t)M * 2048 * 2 <= WS_YA && WS_END <= 256 * MiB, "d_ws map");
constexpr int CW_BAR = 4096;
constexpr int RING_BYTES = 131072, LDSCTL_OFF = RING_BYTES, MISC_OFF = LDSCTL_OFF + 320, LDS_BYTES = 147456;

__device__ __forceinline__ float wave_sum(float v) {
#pragma unroll
    for (int o = 1; o < 64; o <<= 1) v += __shfl_xor(v, o);
    return v;
}
__device__ __forceinline__ int maprow(int mode, int n) {
    if (mode == 1) { if (n < FF) return 256 * (n / 128) + (n % 128); const int j = n - FF; return 256 * (j / 128) + 128 + (j % 128); }
    if (mode == 2) { if (n < 512 || n >= 1536) return n; const int j = (n - 512) & 511, second = (n >= 1024) ? 128 : 0; return 512 + 256 * (j / 128) + second + (j % 128); }
    return n;
}
__device__ __forceinline__ void transpose_item(const float* W, int K, int N, bf16* WT, const float* gain, int mode, LAS float* scr, int item, int lane) {
    const int nblk = N / 32, kb = item / nblk, nb = item % nblk, k0 = 64 * kb, n0 = 32 * nb;
#pragma unroll 8
    for (int i = 0; i < 32; ++i) { const int kk = 2 * i + (lane >> 5); float w = W[(size_t)(k0 + kk) * N + n0 + (lane & 31)]; if (gain) w *= gain[k0 + kk]; scr[kk * 33 + (lane & 31)] = w; }
    LDS_WAIT(); asm volatile("" ::: "memory");
    const int c = lane & 7, nd0 = maprow(mode, n0);
#pragma unroll
    for (int j = 0; j < 4; ++j) { const int n = (lane >> 3) + 8 * j; const LAS float* s = scr + (8 * c) * 33 + n;
        v4u o; o.x = pk2(s[0 * 33], s[1 * 33]); o.y = pk2(s[2 * 33], s[3 * 33]); o.z = pk2(s[4 * 33], s[5 * 33]); o.w = pk2(s[6 * 33], s[7 * 33]);
        *(GAS v4u*)(WT + (size_t)(nd0 + n) * K + k0 + 8 * c) = o; }
    LDS_WAIT(); asm volatile("" ::: "memory");
}

struct Args { const float* in[15]; float* out; unsigned char* ws; int ph_lo, ph_hi, coop, pad; };

__global__ void __launch_bounds__(NWAVES * 64, 2) fwd_kernel(Args args_) {
    extern __shared__ __attribute__((aligned(16))) unsigned char lds[];
    {   LAS unsigned char* L0 = (LAS unsigned char*)lds;
        for (int u = threadIdx.x; u < (LDS_BYTES - LDSCTL_OFF) / 4; u += NWAVES * 64) ((LAS unsigned*)(L0 + LDSCTL_OFF))[u] = 0u;
        __syncthreads();
        if (args_.ph_hi - args_.ph_lo > 1) (void)xcd_barrier_post((unsigned*)(args_.ws + WS_CTL) + CW_BAR, (volatile LAS unsigned*)(L0 + MISC_OFF) + 8); }
    const int lo = args_.ph_lo, hi = args_.ph_hi;
    for (int ph = lo; ph < hi; ++ph) {
#if defined(PROBE_S0)
        const int reps = (ph != N_PHASES - 1 && (ph % 9 == PROBE_S0 || ph % 9 == PROBE_S1)) ? 2 : 1;
#else
        const int reps = 1;
#endif
        for (int rep = 0; rep < reps; ++rep) {
        const __attribute__((address_space(4))) Args* ap = (const __attribute__((address_space(4))) Args*)__builtin_amdgcn_kernarg_segment_ptr();
        asm volatile("" : "+s"(ap));
        const __attribute__((address_space(4))) Args& args = *ap;
        LAS unsigned char* L = (LAS unsigned char*)lds;
        const int tid = ltid(), lane = tid & 63, wave = __builtin_amdgcn_readfirstlane(tid >> 6);
        const int G = gridDim.x, bid = blockIdx.x;
        const int vcu = (G % 8 == 0) ? (bid % 8) * (G / 8) + bid / 8 : bid;
        unsigned char* ws = args.ws;
        const int gw = vcu * NWAVES + wave, NGW = G * NWAVES;
        const int l = ph / 9, s = ph % 9;
        if (ph == N_PHASES - 1) {
            const float* gfin = args.in[14]; float* const out = args.out;
            for (int m = gw; m < M; m += NGW) { GAS f32x4* xr = (GAS f32x4*)(out + (size_t)m * D) + lane; f32x4 v[4]; float sq = 0.f;
#pragma unroll
                for (int j = 0; j < 4; ++j) { v[j] = xr[64 * j]; sq += (v[j].x * v[j].x + v[j].y * v[j].y) + (v[j].z * v[j].z + v[j].w * v[j].w); }
                const float rs = 1.0f / sqrtf(wave_sum(sq) * (1.0f / D) + 1e-6f);
#pragma unroll
                for (int j = 0; j < 4; ++j) { const f32x4 gg = *((const f32x4*)gfin + 64 * j + lane); xr[64 * j] = v[j] * rs * gg; } }
        } else if (s == 0) {
            LAS float* scr = (LAS float*)(L + wave * 16384);
            const float* w13a = args.in[2] + (size_t)l * D * 2 * FF; const float* w2a = args.in[3] + (size_t)l * FF * D; const float* win = args.in[5] + (size_t)l * D * NIN;
            const float* wc = args.in[8] + (size_t)l * 512 * D; const float* wa = args.in[9] + (size_t)l * 512 * D; const float* wo = args.in[10] + (size_t)l * D * D;
            const float* w13b = args.in[12] + (size_t)l * D * 2 * FF; const float* w2b = args.in[13] + (size_t)l * FF * D;
            const float* g1 = args.in[1] + l * D; const float* gm = args.in[4] + l * D; const float* g2 = args.in[11] + l * D;
            constexpr int I13 = (D / 64) * (2 * FF / 32), I2 = (FF / 64) * (D / 32), IIN = (D / 64) * (NIN / 32), ICO = (512 / 64) * (D / 32), IO = (D / 64) * (D / 32);
            constexpr int NITEMS = 2 * I13 + 2 * I2 + IIN + 2 * ICO + IO;
            for (int it = gw; it < NITEMS; it += NGW) {
                int r = it;
                if (r < I13) { transpose_item(w13a, D, 2 * FF, (bf16*)(ws + WS_W13A), g1, 1, scr, r, lane); continue; } r -= I13;
                if (r < I13) { transpose_item(w13b, D, 2 * FF, (bf16*)(ws + WS_W13B), g2, 1, scr, r, lane); continue; } r -= I13;
                if (r < IIN) { transpose_item(win, D, NIN, (bf16*)(ws + WS_WIN), gm, 2, scr, r, lane); continue; } r -= IIN;
                if (r < I2) { transpose_item(w2a, FF, D, (bf16*)(ws + WS_W2A), nullptr, 0, scr, r, lane); continue; } r -= I2;
                if (r < I2) { transpose_item(w2b, FF, D, (bf16*)(ws + WS_W2B), nullptr, 0, scr, r, lane); continue; } r -= I2;
                if (r < IO) { transpose_item(wo, D, D, (bf16*)(ws + WS_WO), nullptr, 0, scr, r, lane); continue; } r -= IO;
                if (r < ICO) { transpose_item(wc, 512, D, (bf16*)(ws + WS_WC), nullptr, 0, scr, r, lane); continue; } r -= ICO;
                transpose_item(wa, 512, D, (bf16*)(ws + WS_WA), nullptr, 0, scr, r, lane);
            }
            if (l == 0) {
                const float* x = args.in[0]; bf16* const XB = (bf16*)(ws + WS_XB); float* const ssq = (float*)(ws + WS_SSQ);
                for (int m = gw; m < M; m += NGW) { const GAS f32x4* xr = (const GAS f32x4*)(x + (size_t)m * D) + lane; f32x4 v[4]; float sq = 0.f;
#pragma unroll
                    for (int j = 0; j < 4; ++j) { v[j] = xr[64 * j]; sq += (v[j].x * v[j].x + v[j].y * v[j].y) + (v[j].z * v[j].z + v[j].w * v[j].w); }
                    sq = wave_sum(sq);
                    GAS unsigned long long* o8 = (GAS unsigned long long*)(XB + (size_t)m * D) + lane;
#pragma unroll
                    for (int j = 0; j < 4; ++j) o8[64 * j] = (unsigned long long)pk2(v[j].x, v[j].y) | ((unsigned long long)pk2(v[j].z, v[j].w) << 32);
                    if (lane < 16) ssq[(size_t)m * 16 + lane] = lane == 0 ? sq : 0.f; }
            }
        } else if (s == 4) {
            const float* cw = args.in[7] + (size_t)l * 3 * 512;
            bf16* const CB = (bf16*)(ws + WS_CB); bf16* const U = (bf16*)(ws + WS_U); bf16* const Qb = (bf16*)(ws + WS_Q); bf16* const Kb = (bf16*)(ws + WS_K); bf16* const Vb = (bf16*)(ws + WS_V); bf16* const YA = (bf16*)(ws + WS_YA);
            if (rep == 0) for (int i = bid * (NWAVES * 64) + tid; i < M * 64; i += G * NWAVES * 64) { const int row = i >> 6, c0 = (i & 63) * 8, t = row & (SEQ - 1);
                const pg8::u32x4e zero4 = {0u, 0u, 0u, 0u};
                const pg8::u32x4e cbv = *(const pg8::u32x4e*)(CB + (size_t)row * 512 + c0), u2 = *(const pg8::u32x4e*)(U + (size_t)row * 512 + c0);
                const pg8::u32x4e u1 = t >= 1 ? *(const pg8::u32x4e*)(U + (size_t)(row - 1) * 512 + c0) : zero4, u0 = t >= 2 ? *(const pg8::u32x4e*)(U + (size_t)(row - 2) * 512 + c0) : zero4;
                f32x4 cb0, cb1, a0, a1, b0, b1, c0v, c1v; pg8::unpack8(cbv, cb0, cb1); pg8::unpack8(u0, a0, a1); pg8::unpack8(u1, b0, b1); pg8::unpack8(u2, c0v, c1v);
                const f32x4 w00 = *(const f32x4*)(cw + c0), w01 = *(const f32x4*)(cw + c0 + 4), w10 = *(const f32x4*)(cw + 512 + c0), w11 = *(const f32x4*)(cw + 512 + c0 + 4), w20 = *(const f32x4*)(cw + 1024 + c0), w21 = *(const f32x4*)(cw + 1024 + c0 + 4);
                const f32x4 y0 = cb0 * (w00 * a0 + w10 * b0 + w20 * c0v), y1 = cb1 * (w01 * a1 + w11 * b1 + w21 * c1v);
                *(pg8::u32x4e*)(CB + (size_t)row * 512 + c0) = pg8::pack8(y0, y1); }
            __syncthreads();
            for (int p = vcu; p < 256; p += G) { const int bh = p >> 2, sI = p & 3;
                sba::attn_unit(bh >> 3, bh & 7, 7 - sI, Qb, Kb, Vb, YA, L);
                sba::attn_unit(bh >> 3, bh & 7, sI, Qb, Kb, Vb, YA, L); }
        } else {
            const int ncall = (s == 5) ? 2 : 1;
            for (int c = 0; c < ncall; ++c) {
                pg8::Gemm g{}; pg8::EpiAll E{};
                E.ws = ws; E.outf = args.out; E.base = args.out; E.alpha = 0.5f; E.bgate = args.in[6] + (size_t)l * 2048;
                g.M = M;
                if (s == 1)      { g.A = (const bf16*)(ws + WS_XB);  g.Bt = (const bf16*)(ws + WS_W13A); g.N = 2 * FF; g.K = D;  E.mode = pg8::EP_SWIGLU; }
                else if (s == 2) { g.A = (const bf16*)(ws + WS_ACT); g.Bt = (const bf16*)(ws + WS_W2A);  g.N = D;      g.K = FF; E.mode = pg8::EP_RESID; if (l == 0) E.base = args.in[0]; }
                else if (s == 3) { g.A = (const bf16*)(ws + WS_XB);  g.Bt = (const bf16*)(ws + WS_WIN);  g.N = NIN;    g.K = D;  E.mode = pg8::EP_WIN; }
                else if (s == 5) { if (c == 0) { g.A = (const bf16*)(ws + WS_YA); g.Bt = (const bf16*)(ws + WS_WA); E.mode = pg8::EP_MERGE1; } else { g.A = (const bf16*)(ws + WS_CB); g.Bt = (const bf16*)(ws + WS_WC); E.mode = pg8::EP_MERGE2; } g.N = D; g.K = 512; }
                else if (s == 6) { g.A = (const bf16*)(ws + WS_MG);  g.Bt = (const bf16*)(ws + WS_WO);   g.N = D;      g.K = D;  E.mode = pg8::EP_RESID; E.alpha = 1.0f; }
                else if (s == 7) { g.A = (const bf16*)(ws + WS_XB);  g.Bt = (const bf16*)(ws + WS_W13B); g.N = 2 * FF; g.K = D;  E.mode = pg8::EP_SWIGLU; }
                else             { g.A = (const bf16*)(ws + WS_ACT); g.Bt = (const bf16*)(ws + WS_W2B);  g.N = D;      g.K = FF; E.mode = pg8::EP_RESID; }
                pg8::StaticOrder S; S.init(M, g.N, G, bid);
                pg8::gemm_phase<pg8::EpiAll, pg8::StaticOrder, true, true>(L, g, S, E);
            }
        }
        }
        if (ph + 1 < hi) {
            if (ph == lo && args_.coop) { __threadfence(); cg::this_grid().sync(); }
            else { XcdBarrier bar; bar.bar = (unsigned*)(args_.ws + WS_CTL) + CW_BAR; bar.x = xb_xcc_id(); bar.st = (volatile LAS unsigned*)((LAS unsigned char*)lds + MISC_OFF) + 8; xcd_barrier(bar); }
        }
    }
}

extern "C" void kernel_launch(void* const* d_in, const int* in_sizes, int n_in, void* d_out, int out_size, void* d_ws, size_t ws_size, hipStream_t stream) {
    static int grid = 0;
    if (grid == 0) {
        if (n_in != 15 || in_sizes[0] != M * D || out_size != M * D || ws_size < WS_END) { fprintf(stderr, "kernel_launch: unexpected shapes (n_in %d, in0 %d, out %d, ws %zu); nothing launched\n", n_in, n_in > 0 ? in_sizes[0] : -1, out_size, ws_size); grid = -1; return; }
        int dev = 0, cus = 0, per_cu = 0;
        if (hipGetDevice(&dev) != hipSuccess || hipDeviceGetAttribute(&cus, hipDeviceAttributeMultiprocessorCount, dev) != hipSuccess) { grid = -1; return; }
        if (hipFuncSetAttribute((const void*)fwd_kernel, hipFuncAttributeMaxDynamicSharedMemorySize, LDS_BYTES) != hipSuccess) { fprintf(stderr, "kernel_launch: hipFuncSetAttribute failed\n"); grid = -1; return; }
        if (hipOccupancyMaxActiveBlocksPerMultiprocessor(&per_cu, (const void*)fwd_kernel, NWAVES * 64, LDS_BYTES) != hipSuccess || per_cu < 1) { fprintf(stderr, "kernel_launch: occupancy query says %d blocks per CU; nothing launched\n", per_cu); (void)hipGetLastError(); grid = -1; return; }
        grid = cus < 256 ? cus : 256;
    }
    if (grid < 0) return;
    if (hipMemsetAsync((char*)d_ws + WS_CTL, 0, CTL_ZERO_BYTES, stream) != hipSuccess) { fprintf(stderr, "kernel_launch: hipMemsetAsync failed\n"); return; }
    Args a{};
    for (int i = 0; i < 15; ++i) a.in[i] = (const float*)d_in[i];
    a.out = (float*)d_out; a.ws = (unsigned char*)d_ws;
#if MK_PER_PHASE
    for (int ph = 0; ph < N_PHASES; ++ph) { a.ph_lo = ph; a.ph_hi = ph + 1; a.coop = 0;
        hipLaunchKernelGGL(fwd_kernel, dim3(grid), dim3(NWAVES * 64), LDS_BYTES, stream, a); }
#else
    a.ph_lo = 0; a.ph_hi = N_PHASES; a.coop = 1;
    void* kargs[] = {&a};
    const hipError_t e = hipLaunchCooperativeKernel((const void*)fwd_kernel, dim3(grid), dim3(NWAVES * 64), kargs, LDS_BYTES, stream);
    if (e != hipSuccess) fprintf(stderr, "kernel_launch: cooperative launch failed: %s (grid %d)\n", hipGetErrorString(e), grid);
#endif
}
```

```cpp
#include <hip/hip_runtime.h>
#include <hip/hip_cooperative_groups.h>
#include <cstdio>
#include <cstdint>
namespace cg = cooperative_groups;
__device__ __forceinline__ int ltid() { int t = threadIdx.x; asm volatile("" : "+v"(t)); return t; }
namespace pg8 {
#define PG8_LAS __attribute__((address_space(3)))
typedef unsigned short bf16_t;
typedef short bf16x8 __attribute__((ext_vector_type(8)));
typedef float f32x4 __attribute__((ext_vector_type(4)));
typedef unsigned u32x4 __attribute__((ext_vector_type(4)));
constexpr int BM = 256, BK = 64, HALF = 128, HTB = HALF * BK * 2  , STAGE_BYTES = 8 * HTB, NXCD = 8, WGM = 8;

__host__ __device__ __forceinline__ int lds_byte(int r, int c) { const int st = (r >> 4) * 2 + (c >> 5), rr = r & 15, cc = c & 31, ob = rr * 64 + cc * 2; return st * 1024 + (ob ^ (((ob >> 9) & 1) << 5)); }
__host__ __device__ __forceinline__ void stage_rc(int b, int& R, int& C) { const int st = b / 1024, sb = b % 1024, swz = sb ^ (((sb >> 9) & 1) << 5); R = (st >> 1) * 16 + swz / 64; C = (st & 1) * 32 + (swz % 64) / 2; }
__host__ __device__ __forceinline__ int perm32(int rho) { const int n = rho >> 4, i = rho & 15; return 8 * (i >> 2) + 4 * n + (i & 3); }

struct Unit { int pm, pn; };
struct Gemm { const bf16_t* A; const bf16_t* Bt; int M, N, K; };

struct StaticOrder {
    int nM, nN, nwg, G, c;
    __host__ __device__ void init(int M, int N, int G_, int c_) { nM = M / BM; nN = N / BM; nwg = nM * nN; G = G_; c = c_; }
    __host__ __device__ bool next(int i, Unit& u) const {
        const long L = (long)i * G + c; if (L >= nwg) return false;
        int wgid = (int)L; { const int q = nwg / NXCD, r = nwg % NXCD, xcd = wgid % NXCD, off = wgid / NXCD; wgid = (xcd < r ? xcd * (q + 1) : r * (q + 1) + (xcd - r) * q) + off; }
        const int nig = WGM * nN, gid = wgid / nig, fm = gid * WGM, gsz = (nM - fm) < WGM ? (nM - fm) : WGM;
        u.pm = fm + ((wgid % nig) % gsz); u.pn = (wgid % nig) / gsz; return true;
    }
    __device__ __forceinline__ void a_ready(const Unit&) const {}
    __device__ __forceinline__ void done(const Unit&) const {}
};

__device__ __forceinline__ unsigned cvt_pk_bf16(float lo, float hi) { unsigned r; asm volatile("v_cvt_pk_bf16_f32 %0, %1, %2" : "=v"(r) : "v"(lo), "v"(hi)); return r; }
typedef float f32x2 __attribute__((ext_vector_type(2)));

typedef unsigned u32x4e __attribute__((ext_vector_type(4)));
constexpr float LOG2E = 1.4426950408889634f;
constexpr float QSCALE = 0.125f * LOG2E;
__device__ __forceinline__ float rowscale(const float* ssq, int row) {
    const f32x4* p = (const f32x4*)(ssq + (size_t)row * 16);
    const f32x4 s = (p[0] + p[1]) + (p[2] + p[3]);
    return __builtin_amdgcn_rsqf(((s[0] + s[1]) + (s[2] + s[3])) * (1.0f / 1024.0f) + 1e-6f);
}
__device__ __forceinline__ float sigmoid_f(float x) { return __builtin_amdgcn_rcpf(1.0f + __builtin_amdgcn_exp2f(-x * LOG2E)); }
__device__ __forceinline__ u32x4e pack8(const f32x4 a, const f32x4 b) { u32x4e w; w.x = cvt_pk_bf16(a[0], a[1]); w.y = cvt_pk_bf16(a[2], a[3]); w.z = cvt_pk_bf16(b[0], b[1]); w.w = cvt_pk_bf16(b[2], b[3]); return w; }
__device__ __forceinline__ void unpack8(const u32x4e w, f32x4& a, f32x4& b) {
    a[0] = __uint_as_float(w.x << 16); a[1] = __uint_as_float(w.x & 0xffff0000u); a[2] = __uint_as_float(w.y << 16); a[3] = __uint_as_float(w.y & 0xffff0000u);
    b[0] = __uint_as_float(w.z << 16); b[1] = __uint_as_float(w.z & 0xffff0000u); b[2] = __uint_as_float(w.w << 16); b[3] = __uint_as_float(w.w & 0xffff0000u);
}
constexpr size_t EMiB = 1u << 20;
constexpr size_t EWS_SSQ = 1 * EMiB, EWS_XB = 49 * EMiB, EWS_ACT = 81 * EMiB, EWS_CB = 81 * EMiB, EWS_U = 97 * EMiB, EWS_Q = 113 * EMiB, EWS_K = 129 * EMiB, EWS_V = 145 * EMiB, EWS_G = 161 * EMiB, EWS_MG = 129 * EMiB;
enum { EP_SWIGLU = 0, EP_RESID = 1, EP_WIN = 2, EP_MERGE1 = 3, EP_MERGE2 = 4 };
struct EpiAll {
    static constexpr bool PERM = true, AFTER_DRAIN = false;
    int mode; float alpha;
    unsigned char* ws;
    float* outf;
    const float* base;
    const float* bgate;
    __device__ __forceinline__ void operator()(const f32x4 (&acc)[2][2][4][2], const Unit& u, int wr, int wc, int fr, int fq) const {
        const int row0 = u.pm * BM + wr * 64 + fr, lc = wc * 32 + 8 * fq, pn = u.pn;
        const float* ssq = (const float*)(ws + EWS_SSQ); float* ssq_out = (float*)(ws + EWS_SSQ);
        bf16_t* act = (bf16_t*)(ws + EWS_ACT); bf16_t* xb = (bf16_t*)(ws + EWS_XB);
        bf16_t* cb = (bf16_t*)(ws + EWS_CB); bf16_t* uu = (bf16_t*)(ws + EWS_U); bf16_t* q = (bf16_t*)(ws + EWS_Q); bf16_t* k = (bf16_t*)(ws + EWS_K); bf16_t* v = (bf16_t*)(ws + EWS_V);
        bf16_t* g = (bf16_t*)(ws + EWS_G); bf16_t* mg = (bf16_t*)(ws + EWS_MG);
        if (mode == EP_SWIGLU) {
#pragma unroll
            for (int ai = 0; ai < 2; ++ai)
#pragma unroll
                for (int m = 0; m < 4; ++m) { const int row = row0 + ai * HALF + m * 16; const float rs = rowscale(ssq, row);
                    f32x4 o[2];
#pragma unroll
                    for (int n = 0; n < 2; ++n) { const f32x4 a = acc[ai][0][m][n] * rs, b = acc[ai][1][m][n] * rs;
#pragma unroll
                        for (int e = 0; e < 4; ++e) o[n][e] = a[e] * sigmoid_f(a[e]) * b[e]; }
                    *(u32x4e*)(act + (size_t)row * 2816 + pn * 128 + lc) = pack8(o[0], o[1]); }
        } else if (mode == EP_RESID) {
#pragma unroll
            for (int ai = 0; ai < 2; ++ai)
#pragma unroll
                for (int m = 0; m < 4; ++m) { const int row = row0 + ai * HALF + m * 16; float s = 0.f;
#pragma unroll
                    for (int bj = 0; bj < 2; ++bj) { const size_t off = (size_t)row * 1024 + pn * BM + bj * HALF + lc;
                        const f32x4 x0 = *(const f32x4*)(base + off), x1 = *(const f32x4*)(base + off + 4);
                        const f32x4 y0 = x0 + acc[ai][bj][m][0] * alpha, y1 = x1 + acc[ai][bj][m][1] * alpha;
                        *(f32x4*)(outf + off) = y0; *(f32x4*)(outf + off + 4) = y1; *(u32x4e*)(xb + off) = pack8(y0, y1);
                        s += (y0[0] * y0[0] + y0[1] * y0[1]) + (y0[2] * y0[2] + y0[3] * y0[3]) + (y1[0] * y1[0] + y1[1] * y1[1]) + (y1[2] * y1[2] + y1[3] * y1[3]); }
                    s += __shfl_xor(s, 16); s += __shfl_xor(s, 32);
                    if (fq == 0) ssq_out[(size_t)row * 16 + pn * 4 + wc] = s; }
        } else if (mode == EP_WIN) {
#pragma unroll
            for (int ai = 0; ai < 2; ++ai)
#pragma unroll
                for (int m = 0; m < 4; ++m) { const int row = row0 + ai * HALF + m * 16; const float rs = rowscale(ssq, row);
                    if (pn >= 2 && pn < 6) {
                        const float rs2 = rs * rs;
                        const f32x4 o0 = acc[ai][0][m][0] * acc[ai][1][m][0] * rs2, o1 = acc[ai][0][m][1] * acc[ai][1][m][1] * rs2;
                        *(u32x4e*)(uu + (size_t)row * 512 + (pn - 2) * 128 + lc) = pack8(o0, o1);
                    } else {
#pragma unroll
                        for (int bj = 0; bj < 2; ++bj) { const int col = bj * HALF + lc;
                            if (pn < 2) { *(u32x4e*)(cb + (size_t)row * 512 + pn * BM + col) = pack8(acc[ai][bj][m][0] * rs, acc[ai][bj][m][1] * rs); }
                            else if (pn < 12) { const int t = (pn - 6) >> 1; bf16_t* dst = t == 0 ? q : (t == 1 ? k : v); const float sc = t == 0 ? rs * QSCALE : rs;
                                *(u32x4e*)(dst + (size_t)row * 512 + ((pn - 6) & 1) * BM + col) = pack8(acc[ai][bj][m][0] * sc, acc[ai][bj][m][1] * sc); }
                            else { const int gc = (pn - 12) * BM + col; const f32x4 b0 = *(const f32x4*)(bgate + gc), b1 = *(const f32x4*)(bgate + gc + 4);
                                const f32x4 z0 = acc[ai][bj][m][0] * rs + b0, z1 = acc[ai][bj][m][1] * rs + b1; f32x4 o0, o1;
#pragma unroll
                                for (int e = 0; e < 4; ++e) { o0[e] = sigmoid_f(z0[e]); o1[e] = sigmoid_f(z1[e]); }
                                *(u32x4e*)(g + (size_t)row * 2048 + gc) = pack8(o0, o1); } }
                    } }
        } else {
#pragma unroll
            for (int ai = 0; ai < 2; ++ai)
#pragma unroll
                for (int m = 0; m < 4; ++m) { const int row = row0 + ai * HALF + m * 16;
#pragma unroll
                    for (int bj = 0; bj < 2; ++bj) { const int col = pn * BM + bj * HALF + lc; bf16_t* ga = g + (size_t)row * 2048 + 1024 + col;
                        if (mode == EP_MERGE1) { f32x4 g0, g1; unpack8(*(const u32x4e*)ga, g0, g1); *(u32x4e*)ga = pack8(g0 * acc[ai][bj][m][0], g1 * acc[ai][bj][m][1]); }
                        else { f32x4 g0, g1, m0, m1; unpack8(*(const u32x4e*)(g + (size_t)row * 2048 + col), g0, g1); unpack8(*(const u32x4e*)ga, m0, m1);
                            *(u32x4e*)(mg + (size_t)row * 1024 + col) = pack8(m0 + g0 * acc[ai][bj][m][0], m1 + g1 * acc[ai][bj][m][1]); } } }
        }
    }
};
template <class Epi, class Sched, bool ALIGN_EPI = false, bool SP2 = false>
__device__ __forceinline__ void gemm_phase(PG8_LAS unsigned char* lds, const Gemm g, const Sched& S, const Epi& E) {
    const int tid = ltid(), wid = __builtin_amdgcn_readfirstlane(tid >> 6), lane = tid & 63, wr = wid >> 2, wc = wid & 3, fr = lane & 15, fq = lane >> 4;
    const int K = g.K, nt = K / BK;
    unsigned voffA[2], voffB[2];
#pragma unroll
    for (int i = 0; i < 2; ++i) { int R, C; stage_rc(tid * 16 + i * 8192, R, C); const int Rb = Epi::PERM ? ((R & ~31) + perm32(R & 31)) : R;
        voffA[i] = (unsigned)(R * K + C) * 2u; voffB[i] = (unsigned)(Rb * K + C) * 2u; }
    const size_t kstep = (size_t)(BK * 2);
    const size_t hstep = (size_t)HALF * K * 2;
    const size_t tstep = 2 * hstep;
    const unsigned ldsw = (unsigned)wid * 1024u;
    const int aoff = lds_byte(wr * 64 + fr, fq * 8), boff = lds_byte(wc * 32 + fr, fq * 8);
#define PG8_SA(b, h) (((b) * 2 + (h)) * HTB)
#define PG8_SB(b, h) ((4 + (b) * 2 + (h)) * HTB)
#define PG8_STAGE(bufoff, gbase, voff) do { _Pragma("unroll") for (int _i = 0; _i < 2; ++_i) \
        __builtin_amdgcn_global_load_lds((const unsigned*)((const char*)(gbase) + (voff)[_i]), (PG8_LAS unsigned*)(lds + (bufoff) + ldsw + _i * 8192), 16, 0, 0); } while (0)
#define PG8_LDA(dst, b, h) do { _Pragma("unroll") for (int m = 0; m < 4; ++m) _Pragma("unroll") for (int k = 0; k < 2; ++k) dst[m][k] = *(const PG8_LAS bf16x8*)(lds + PG8_SA(b, h) + aoff + m * 2048 + k * 1024); } while (0)
#define PG8_LDB(dst, b, h) do { _Pragma("unroll") for (int n = 0; n < 2; ++n) _Pragma("unroll") for (int k = 0; k < 2; ++k) dst[n][k] = *(const PG8_LAS bf16x8*)(lds + PG8_SB(b, h) + boff + n * 2048 + k * 1024); } while (0)
#define PG8_MMA(ai, bj, At, Bt) do { __builtin_amdgcn_s_setprio(1); _Pragma("unroll") for (int m = 0; m < 4; ++m) _Pragma("unroll") for (int n = 0; n < 2; ++n) _Pragma("unroll") for (int k = 0; k < 2; ++k) \
        acc[ai][bj][m][n] = __builtin_amdgcn_mfma_f32_16x16x32_bf16(Bt[n][k], At[m][k], acc[ai][bj][m][n], 0, 0, 0); __builtin_amdgcn_s_setprio(0); } while (0)
#define PG8_WAIT_V(n) asm volatile("s_waitcnt vmcnt(" #n ")" ::: "memory")
#define PG8_WAIT_L(n) asm volatile("s_waitcnt lgkmcnt(" #n ")" ::: "memory")
#define PG8_BAR __builtin_amdgcn_s_barrier()
#define PG8_SCHED __builtin_amdgcn_sched_barrier(0)
    Unit cur, nxt; int ui = 0;
    if (!S.next(0, cur)) return;
    f32x4 acc[2][2][4][2];
#pragma unroll
    for (int a = 0; a < 2; ++a)
#pragma unroll
        for (int b = 0; b < 2; ++b)
#pragma unroll
            for (int m = 0; m < 4; ++m)
#pragma unroll
                for (int n = 0; n < 2; ++n) acc[a][b][m][n] = (f32x4){0.f, 0.f, 0.f, 0.f};
    bf16x8 At[4][2], B0[2][2], B1[2][2];
    const char* cA = (const char*)g.A + (size_t)cur.pm * tstep; const char* cB = (const char*)g.Bt + (size_t)cur.pn * tstep;
    S.a_ready(cur);
    if constexpr (SP2) {
        PG8_STAGE(PG8_SB(0, 0), cB, voffB); PG8_STAGE(PG8_SB(0, 1), cB + hstep, voffB); PG8_STAGE(PG8_SA(0, 0), cA, voffA); PG8_STAGE(PG8_SA(0, 1), cA + hstep, voffA);
        if (wr == 1) PG8_BAR;
        PG8_WAIT_V(2); PG8_BAR;
        PG8_STAGE(PG8_SB(1, 0), cB + kstep, voffB); PG8_STAGE(PG8_SA(1, 0), cA + kstep, voffA); PG8_STAGE(PG8_SB(1, 1), cB + hstep + kstep, voffB);
        PG8_WAIT_V(6); PG8_BAR;
    } else {
        PG8_STAGE(PG8_SB(0, 0), cB, voffB); PG8_STAGE(PG8_SA(0, 0), cA, voffA); PG8_STAGE(PG8_SB(0, 1), cB + hstep, voffB); PG8_STAGE(PG8_SA(0, 1), cA + hstep, voffA);
        if (wr == 1) PG8_BAR;
        PG8_WAIT_V(4); PG8_BAR;
        PG8_STAGE(PG8_SB(1, 0), cB + kstep, voffB); PG8_STAGE(PG8_SA(1, 0), cA + kstep, voffA); PG8_STAGE(PG8_SB(1, 1), cB + hstep + kstep, voffB);
        PG8_WAIT_V(6); PG8_BAR;
    }
    for (;;) {
        const bool has_next = S.next(ui + 1, nxt);
        const char* nA = has_next ? (const char*)g.A + (size_t)nxt.pm * tstep : cA; const char* nB = has_next ? (const char*)g.Bt + (size_t)nxt.pn * tstep : cB;
        for (int t = 0; t < nt; t += 2) {
            const bool last = (t == nt - 2);
            const char* a1 = cA + (size_t)(t + 1) * kstep;
            const char* a2 = last ? nA : cA + (size_t)(t + 2) * kstep; const char* b2 = last ? nB : cB + (size_t)(t + 2) * kstep;
            const char* a3 = a2 + kstep; const char* b3 = b2 + kstep;
            if (last && has_next) S.a_ready(nxt);
            if constexpr (SP2) {
            PG8_LDB(B0, 0, 0); PG8_LDB(B1, 0, 1); PG8_SCHED; PG8_LDA(At, 0, 0); PG8_STAGE(PG8_SA(1, 1), a1 + hstep, voffA);
            PG8_WAIT_V(8); PG8_WAIT_L(0); PG8_BAR; PG8_MMA(0, 0, At, B0); PG8_MMA(0, 1, At, B1); PG8_BAR; PG8_SCHED;
            PG8_LDA(At, 0, 1); PG8_STAGE(PG8_SB(0, 0), b2, voffB); PG8_STAGE(PG8_SB(0, 1), b2 + hstep, voffB); PG8_STAGE(PG8_SA(0, 0), a2, voffA);
            PG8_WAIT_V(8); PG8_WAIT_L(0); PG8_BAR; PG8_MMA(1, 0, At, B0); PG8_MMA(1, 1, At, B1); PG8_BAR; PG8_SCHED;
            PG8_LDB(B0, 1, 0); PG8_LDB(B1, 1, 1); PG8_SCHED; PG8_LDA(At, 1, 0); PG8_STAGE(PG8_SA(0, 1), a2 + hstep, voffA);
            PG8_WAIT_V(8); PG8_WAIT_L(0); PG8_BAR; PG8_MMA(0, 0, At, B0); PG8_MMA(0, 1, At, B1); PG8_BAR; PG8_SCHED;
            PG8_LDA(At, 1, 1); PG8_STAGE(PG8_SB(1, 0), b3, voffB); PG8_STAGE(PG8_SB(1, 1), b3 + hstep, voffB); PG8_STAGE(PG8_SA(1, 0), a3, voffA);
            PG8_WAIT_V(8); PG8_WAIT_L(0); PG8_BAR; PG8_MMA(1, 0, At, B0); PG8_MMA(1, 1, At, B1); PG8_BAR; PG8_SCHED;
            } else {
            PG8_LDB(B0, 0, 0); PG8_SCHED; PG8_LDA(At, 0, 0); PG8_STAGE(PG8_SA(1, 1), a1 + hstep, voffA);
            PG8_WAIT_L(8); PG8_BAR; PG8_WAIT_L(0); PG8_MMA(0, 0, At, B0); PG8_BAR; PG8_SCHED;
            PG8_LDB(B1, 0, 1); PG8_STAGE(PG8_SB(0, 0), b2, voffB);
            PG8_BAR; PG8_WAIT_L(0); PG8_MMA(0, 1, At, B1); PG8_BAR;
            PG8_LDA(At, 0, 1); PG8_STAGE(PG8_SA(0, 0), a2, voffA);
            PG8_BAR; PG8_WAIT_L(0); PG8_MMA(1, 0, At, B0); PG8_BAR; PG8_SCHED;
            PG8_STAGE(PG8_SB(0, 1), b2 + hstep, voffB);
            PG8_WAIT_V(6); PG8_BAR; PG8_MMA(1, 1, At, B1); PG8_BAR;
            PG8_LDB(B0, 1, 0); PG8_SCHED; PG8_LDA(At, 1, 0); PG8_STAGE(PG8_SA(0, 1), a2 + hstep, voffA);
            PG8_WAIT_L(8); PG8_BAR; PG8_WAIT_L(0); PG8_MMA(0, 0, At, B0); PG8_BAR; PG8_SCHED;
            PG8_LDB(B1, 1, 1); PG8_STAGE(PG8_SB(1, 0), b3, voffB);
            PG8_BAR; PG8_WAIT_L(0); PG8_MMA(0, 1, At, B1); PG8_BAR;
            PG8_LDA(At, 1, 1); PG8_STAGE(PG8_SA(1, 0), a3, voffA);
            PG8_BAR; PG8_WAIT_L(0); PG8_MMA(1, 0, At, B0); PG8_BAR; PG8_SCHED;
            PG8_STAGE(PG8_SB(1, 1), b3 + hstep, voffB);
            PG8_WAIT_V(6); PG8_BAR; PG8_MMA(1, 1, At, B1); PG8_BAR;
            }
        }
        if constexpr (ALIGN_EPI) { if (wr == 0) PG8_BAR; }
        if constexpr (!Epi::AFTER_DRAIN) { E(acc, cur, wr, wc, fr, fq); S.done(cur); }
        if (!has_next) break;
#pragma unroll
        for (int a = 0; a < 2; ++a)
#pragma unroll
            for (int b = 0; b < 2; ++b)
#pragma unroll
                for (int m = 0; m < 4; ++m)
#pragma unroll
                    for (int n = 0; n < 2; ++n) acc[a][b][m][n] = (f32x4){0.f, 0.f, 0.f, 0.f};
        cur = nxt; cA = nA; cB = nB; ++ui;
        if constexpr (ALIGN_EPI) { if (wr == 1) PG8_BAR; }
    }
    PG8_WAIT_V(0);
    if constexpr (!ALIGN_EPI) { if (wr == 0) PG8_BAR; }
    PG8_BAR;
    if constexpr (Epi::AFTER_DRAIN) { E.fused(acc, cur, wr, wc, fr, fq, lds, wid, lane); S.done(cur); }
#undef PG8_SA
#undef PG8_SB
#undef PG8_STAGE
#undef PG8_LDA
#undef PG8_LDB
#undef PG8_MMA
#undef PG8_WAIT_V
#undef PG8_WAIT_L
#undef PG8_BAR
#undef PG8_SCHED
}
}
#define GAS __attribute__((address_space(1)))
#define LAS __attribute__((address_space(3)))
typedef unsigned short bf16;
typedef unsigned v4u __attribute__((ext_vector_type(4)));
typedef float f32x4 __attribute__((ext_vector_type(4)));
typedef short bf16x8 __attribute__((ext_vector_type(8)));
typedef GAS unsigned gu32;
typedef GAS unsigned long long gu64;
#define RLX_AGENT __ATOMIC_RELAXED, __HIP_MEMORY_SCOPE_AGENT
#define LDS_WAIT() asm volatile("s_waitcnt lgkmcnt(0)" ::: "memory")
#define VM_WAIT() asm volatile("s_waitcnt vmcnt(0)" ::: "memory")
__device__ __forceinline__ unsigned long long rt() { return __builtin_amdgcn_s_memrealtime(); }
__device__ __forceinline__ unsigned f2bf(float f) { unsigned u = __builtin_bit_cast(unsigned, f); return (u + 0x7fffu + ((u >> 16) & 1u)) >> 16; }
__device__ __forceinline__ unsigned pk2(float lo, float hi) { return f2bf(lo) | (f2bf(hi) << 16); }
#define XB_TMO      128
#define XB_XCNT(j)  (256  + 64 * (j))
#define XB_XSUB(j)  (1280 + 64 * (j))
#define XB_XGEN(j)  (2304 + 64 * (j))
#define XB_TOP      3328
#define XB_TOPGEN   3392
#define XCD_BAR_WORDS 3456
#define XB_SPIN_CAP (1u << 18)

__device__ __forceinline__ unsigned xb_ld(unsigned* p)              { return __hip_atomic_load(p, __ATOMIC_RELAXED, __HIP_MEMORY_SCOPE_AGENT); }
__device__ __forceinline__ unsigned xb_add(unsigned* p, unsigned v) { return __hip_atomic_fetch_add(p, v, __ATOMIC_RELAXED, __HIP_MEMORY_SCOPE_AGENT); }
__device__ __forceinline__ unsigned xb_xcc_id() { return (unsigned)__builtin_amdgcn_s_getreg((3 << 11) | 20) & 0xFu; }
#define XB_SPIN(cond, bar) do { unsigned _sp = 0; while (cond) { __builtin_amdgcn_s_sleep(1); \
    if ((++_sp & 255u) == 0u) { if (xb_ld(&(bar)[XB_TMO])) break; if (_sp > XB_SPIN_CAP) { atomicAdd(&(bar)[XB_TMO], 1u); break; } } } } while (0)

struct XcdBarrier {
    unsigned* bar; unsigned x;
    volatile LAS unsigned* st;
};

__device__ __forceinline__ XcdBarrier xcd_barrier_post(unsigned* bar, volatile LAS unsigned* st) {
    XcdBarrier b; b.bar = bar; b.x = xb_xcc_id(); b.st = st;
    if (threadIdx.x == 0) (void)xb_add(&bar[XB_XCNT(b.x)], 1u);
    return b;
}
__device__ __forceinline__ void xcd_barrier_complete(unsigned* bar, unsigned x, unsigned& nloc, unsigned& nx) {
    const unsigned G = gridDim.x * gridDim.y * gridDim.z;
    unsigned sum, cnt, mine, sp = 0u;
    for (;;) {
        sum = 0u; cnt = 0u; mine = 0u;
#pragma unroll
        for (unsigned j = 0; j < 16; ++j) { const unsigned c = xb_ld(&bar[XB_XCNT(j)]); sum += c; cnt += (c > 0u) ? 1u : 0u; mine = (j == x) ? c : mine; }
        if (sum == G) break;
        __builtin_amdgcn_s_sleep(1);
        if ((++sp & 255u) == 0u) { if (xb_ld(&bar[XB_TMO])) break; if (sp > XB_SPIN_CAP) { atomicAdd(&bar[XB_TMO], 1u); break; } }
    }
    nloc = mine > 0u ? mine : 1u; nx = cnt > 0u ? cnt : 1u;
}

__device__ __forceinline__ void xcd_barrier(const XcdBarrier& b) {
    asm volatile("s_waitcnt vmcnt(0)" ::: "memory");
    __syncthreads();
    if (threadIdx.x == 0) {
        unsigned* bar = b.bar;
        __builtin_amdgcn_s_waitcnt(0);
        unsigned nloc = b.st[0], nx = b.st[1];
        if (nloc == 0u) { xcd_barrier_complete(bar, b.x, nloc, nx); b.st[0] = nloc; b.st[1] = nx; }
        const unsigned old = xb_add(&bar[XB_XSUB(b.x)], 1u);
        const unsigned gen = old / nloc;
        if (old + 1u == (gen + 1u) * nloc) {
            __builtin_amdgcn_fence(__ATOMIC_RELEASE, "agent");
            asm volatile("s_waitcnt vmcnt(0)" ::: "memory");
            const unsigned og = xb_add(&bar[XB_TOP], 1u);
            const unsigned tg = og / nx;
            if (og + 1u == (tg + 1u) * nx) xb_add(&bar[XB_TOPGEN], 1u);
            else XB_SPIN(xb_ld(&bar[XB_TOPGEN]) == tg, bar);
            __builtin_amdgcn_fence(__ATOMIC_ACQUIRE, "agent");
            xb_add(&bar[XB_XGEN(b.x)], 1u);
            asm volatile("s_waitcnt vmcnt(0)" ::: "memory");
        } else {
            XB_SPIN(xb_ld(&bar[XB_XGEN(b.x)]) == gen, bar);
            __builtin_amdgcn_fence(__ATOMIC_ACQUIRE, "agent");
            asm volatile("s_waitcnt vmcnt(0)" ::: "memory");
        }
    }
    __syncthreads();
}

namespace sba {
#define LAS3 __attribute__((address_space(3)))
typedef short bf16x8 __attribute__((ext_vector_type(8)));
typedef short s16x4 __attribute__((ext_vector_type(4)));
typedef float f32x16 __attribute__((ext_vector_type(16)));
typedef unsigned u32x4 __attribute__((ext_vector_type(4)));
typedef short v4i16_t __attribute__((ext_vector_type(4)));
typedef unsigned short bf16;
constexpr int SEQ = 2048, PITCH = 512, HD = 64;
__host__ __device__ __forceinline__ constexpr int crow(int r, int hi) { return (r & 3) + 8 * (r >> 2) + 4 * hi; }
__device__ __forceinline__ unsigned cvtpk(float lo, float hi) { unsigned r; asm volatile("v_cvt_pk_bf16_f32 %0, %1, %2" : "=v"(r) : "v"(lo), "v"(hi)); return r; }
__device__ __forceinline__ s16x4 vtr(LAS3 const unsigned char* p) { return __builtin_bit_cast(s16x4, __builtin_amdgcn_ds_read_tr16_b64_v4i16((LAS3 v4i16_t*)p)); }

template <bool PARTIAL>
__device__ __forceinline__ void tile(f32x16 (&o)[2], float& carry, const bf16x8 (&qr)[4], LAS3 const unsigned char* Kslot, LAS3 const unsigned char* Vslot, int lim, int r32, int hi, int lane) {
    f32x16 p0 = {}, p1 = {};
    LAS3 const unsigned char* kb = Kslot + hi * 1024 + r32 * 16;
#pragma unroll
    for (int d0 = 0; d0 < 4; ++d0) {
        const bf16x8 b0 = *(LAS3 const bf16x8*)(kb + d0 * 2048), b1 = *(LAS3 const bf16x8*)(kb + d0 * 2048 + 512);
        p0 = __builtin_amdgcn_mfma_f32_32x32x16_bf16(b0, qr[d0], p0, 0, 0, 0);
        p1 = __builtin_amdgcn_mfma_f32_32x32x16_bf16(b1, qr[d0], p1, 0, 0, 0);
    }
    float kp[32], be[32];
#pragma unroll
    for (int i = 0; i < 32; ++i) {
        const float z = i < 16 ? p0[i] : p1[i - 16];
        const float t = __builtin_amdgcn_exp2f(-__builtin_fabsf(z));
        const float rr = __builtin_amdgcn_rcpf(1.0f + t), uu = t * rr;
        const bool pos = z >= 0.f;
        float b_ = pos ? rr : uu, k_ = pos ? uu : rr;
        if (PARTIAL) { const int c = crow(i & 15, 0) + (i >> 4) * 32; const bool valid = c < lim; b_ = valid ? b_ : 0.f; k_ = valid ? k_ : 1.f; }
        be[i] = b_; kp[i] = k_;
    }
    float E[16];
#pragma unroll
    for (int g = 0; g < 8; ++g) {
        const float gp = (kp[4 * g] * kp[4 * g + 1]) * (kp[4 * g + 2] * kp[4 * g + 3]);
        auto rr = __builtin_amdgcn_permlane32_swap(__float_as_uint(gp), __float_as_uint(gp), false, false);
        E[2 * g] = __uint_as_float(rr[0]); E[2 * g + 1] = __uint_as_float(rr[1]);
    }
    float SP[16]; SP[15] = carry;
#pragma unroll
    for (int k = 14; k >= 0; --k) SP[k] = SP[k + 1] * E[k + 1];
    carry = SP[0] * E[0];
    float a[32];
#pragma unroll
    for (int g = 0; g < 8; ++g) {
        float x = hi ? SP[2 * g + 1] : SP[2 * g];
        a[4 * g + 3] = be[4 * g + 3] * x; x *= kp[4 * g + 3];
        a[4 * g + 2] = be[4 * g + 2] * x; x *= kp[4 * g + 2];
        a[4 * g + 1] = be[4 * g + 1] * x; x *= kp[4 * g + 1];
        a[4 * g] = be[4 * g] * x;
    }
    u32x4 pw[4];
#pragma unroll
    for (int ks = 0; ks < 4; ++ks) { pw[ks].x = cvtpk(a[8 * ks], a[8 * ks + 1]); pw[ks].y = cvtpk(a[8 * ks + 2], a[8 * ks + 3]); pw[ks].z = cvtpk(a[8 * ks + 4], a[8 * ks + 5]); pw[ks].w = cvtpk(a[8 * ks + 6], a[8 * ks + 7]); }
    LAS3 const unsigned char* vb = Vslot + ((lane >> 4) & 1) * 32 + (lane & 3) * 8 + (4 * hi + ((lane & 15) >> 2)) * 64;
#pragma unroll
    for (int d0 = 0; d0 < 2; ++d0)
#pragma unroll
        for (int ks = 0; ks < 4; ++ks) {
            const s16x4 lo = vtr(vb + d0 * 4096 + ks * 1024), h4 = vtr(vb + d0 * 4096 + ks * 1024 + 512);
            const bf16x8 vf = (bf16x8){lo[0], lo[1], lo[2], lo[3], h4[0], h4[1], h4[2], h4[3]};
            o[d0] = __builtin_amdgcn_mfma_f32_32x32x16_bf16(__builtin_bit_cast(bf16x8, pw[ks]), vf, o[d0], 0, 0, 0);
        }
}

__device__ __forceinline__ void attn_unit(int b, int h, int qb, const bf16* Q, const bf16* K, const bf16* V, bf16* O, LAS3 unsigned char* lds) {
    const int tid = ltid(), lane = tid & 63, r32 = lane & 31, hi = lane >> 5; const int wid = __builtin_amdgcn_readfirstlane(tid >> 6);
    const size_t rowbase = (size_t)b * SEQ; const int q0 = qb * 256;
    const int myq = q0 + wid * 32 + r32;
    const bf16* Qw = Q + (rowbase + myq) * PITCH + h * HD;
    bf16x8 qr[4];
#pragma unroll
    for (int d0 = 0; d0 < 4; ++d0) qr[d0] = *(const bf16x8*)(Qw + d0 * 16 + hi * 8);
    const bf16* ksrc = K + (rowbase + lane) * PITCH + h * HD + wid * 8;
    const bf16* vsrc = V + (rowbase + 16 * (wid & 3) + (lane >> 2)) * PITCH + h * HD + (wid >> 2) * 32 + (lane & 3) * 8;
    const int stoff = wid * 1024 + lane * 16;
    const int NT = 4 * qb + 4;
    u32x4 kreg = *(const u32x4*)(ksrc + (size_t)(NT - 1) * 64 * PITCH), vreg = *(const u32x4*)(vsrc + (size_t)(NT - 1) * 64 * PITCH);
    *(LAS3 u32x4*)(lds + stoff) = kreg; *(LAS3 u32x4*)(lds + 16384 + stoff) = vreg;
    __syncthreads();
    f32x16 o[2]; o[0] = f32x16{}; o[1] = f32x16{};
    float carry = 1.f; int buf = 0;
    const int tmin = q0 + wid * 32, tmax = tmin + 31;
    for (int j = NT - 1; j >= 0; --j) {
        if (j > 0) { kreg = *(const u32x4*)(ksrc + (size_t)(j - 1) * 64 * PITCH); vreg = *(const u32x4*)(vsrc + (size_t)(j - 1) * 64 * PITCH); }
        if (64 * j < tmax) {
            const int lim = myq - 64 * j - 4 * hi;
            if (64 * j + 63 >= tmin) tile<true>(o, carry, qr, lds + buf * 8192, lds + 16384 + buf * 8192, lim, r32, hi, lane);
            else tile<false>(o, carry, qr, lds + buf * 8192, lds + 16384 + buf * 8192, lim, r32, hi, lane);
        }
        if (j > 0) { *(LAS3 u32x4*)(lds + (buf ^ 1) * 8192 + stoff) = kreg; *(LAS3 u32x4*)(lds + 16384 + (buf ^ 1) * 8192 + stoff) = vreg; }
        __syncthreads();
        buf ^= 1;
    }
    bf16* Ow = O + (rowbase + q0 + wid * 32) * PITCH + h * HD + r32;
#pragma unroll
    for (int r = 0; r < 16; ++r) { const int orow = crow(r, 0) + 4 * hi;
#pragma unroll
        for (int d0 = 0; d0 < 2; ++d0) Ow[(size_t)orow * PITCH + d0 * 32] = (bf16)(cvtpk(o[d0][r], 0.f) & 0xffffu); }
}
}

constexpr int NWAVES = 8;
constexpr int BATCH = 8, SEQ = 2048, D = 1024, DEPTH = 2, FF = 2816, NIN = 5120;
constexpr int M = BATCH * SEQ;
constexpr int N_PHASES = 9 * DEPTH + 1;
#ifndef MK_PER_PHASE
#define MK_PER_PHASE 0
#endif
constexpr size_t KiB = 1024, MiB = 1u << 20;
constexpr size_t WS_CTL = 0, CTL_ZERO_BYTES = 64 * KiB;
constexpr size_t WS_SSQ = 1 * MiB;
constexpr size_t WS_W13A = 2048 * KiB, WS_W2A = 13312 * KiB, WS_WIN = 18944 * KiB, WS_WC = 29184 * KiB, WS_WA = 30208 * KiB, WS_WO = 31232 * KiB, WS_W13B = 33280 * KiB, WS_W2B = 44544 * KiB;
constexpr size_t WS_XB = 49 * MiB;
constexpr size_t WS_ACT = 81 * MiB;
constexpr size_t WS_CB = 81 * MiB, WS_U = 97 * MiB, WS_Q = 113 * MiB, WS_K = 129 * MiB, WS_V = 145 * MiB, WS_G = 161 * MiB, WS_MG = 129 * MiB, WS_YA = 225 * MiB, WS_END = 241 * MiB;
static_assert(WS_SSQ == pg8::EWS_SSQ && WS_XB == pg8::EWS_XB && WS_ACT == pg8::EWS_ACT && WS_CB == pg8::EWS_CB && WS_U == pg8::EWS_U && WS_Q == pg8::EWS_Q && WS_K == pg8::EWS_K && WS_V == pg8::EWS_V && WS_G == pg8::EWS_G && WS_MG == pg8::EWS_MG, "d_ws map shared with the epilogue");
static_assert(WS_W2B + (size_t)D * FF * 2 <= WS_XB && WS_ACT + (size_t)M * FF * 2 <= 256 * MiB && WS_G + (size_t)M * 2048 * 2 <= WS_YA && WS_END <= 256 * MiB, "d_ws map");
constexpr int CW_BAR = 4096;
constexpr int RING_BYTES = 131072, LDSCTL_OFF = RING_BYTES, MISC_OFF = LDSCTL_OFF + 320, LDS_BYTES = 147456;

__device__ __forceinline__ float wave_sum(float v) {
#pragma unroll
    for (int o = 1; o < 64; o <<= 1) v += __shfl_xor(v, o);
    return v;
}
__device__ __forceinline__ int maprow(int mode, int n) {
    if (mode == 1) { if (n < FF) return 256 * (n / 128) + (n % 128); const int j = n - FF; return 256 * (j / 128) + 128 + (j % 128); }
    if (mode == 2) { if (n < 512 || n >= 1536) return n; const int j = (n - 512) & 511, second = (n >= 1024) ? 128 : 0; return 512 + 256 * (j / 128) + second + (j % 128); }
    return n;
}
__device__ __forceinline__ void transpose_item(const float* W, int K, int N, bf16* WT, const float* gain, int mode, int item, int lane) {
    const int nblk = N / 64, kb = item / nblk, nb = item % nblk, k0 = 64 * kb, n0 = 64 * nb;
    const int r4 = lane >> 4, c4 = (lane & 15) * 4;
    f32x4 v[16];
#pragma unroll
    for (int i = 0; i < 16; ++i) v[i] = *(const GAS f32x4*)(W + (size_t)(k0 + 16 * r4 + i) * N + n0 + c4);
    if (gain) {
#pragma unroll
        for (int i = 0; i < 16; ++i) v[i] = v[i] * gain[k0 + 16 * r4 + i]; }
    const int nd0 = maprow(mode, n0);
#pragma unroll
    for (int e = 0; e < 4; ++e)
#pragma unroll
        for (int h2 = 0; h2 < 2; ++h2) { v4u o; o.x = pk2(v[8 * h2][e], v[8 * h2 + 1][e]); o.y = pk2(v[8 * h2 + 2][e], v[8 * h2 + 3][e]); o.z = pk2(v[8 * h2 + 4][e], v[8 * h2 + 5][e]); o.w = pk2(v[8 * h2 + 6][e], v[8 * h2 + 7][e]);
            *(GAS v4u*)(WT + (size_t)(nd0 + c4 + e) * K + k0 + 16 * r4 + 8 * h2) = o; }
}

struct Args { const float* in[15]; float* out; unsigned char* ws; int ph_lo, ph_hi, coop, pad; };

__global__ void __launch_bounds__(NWAVES * 64, 2) fwd_kernel(Args args_) {
    extern __shared__ __attribute__((aligned(16))) unsigned char lds[];
    {   LAS unsigned char* L0 = (LAS unsigned char*)lds;
        for (int u = threadIdx.x; u < (LDS_BYTES - LDSCTL_OFF) / 4; u += NWAVES * 64) ((LAS unsigned*)(L0 + LDSCTL_OFF))[u] = 0u;
        __syncthreads();
        if (args_.ph_hi - args_.ph_lo > 1) (void)xcd_barrier_post((unsigned*)(args_.ws + WS_CTL) + CW_BAR, (volatile LAS unsigned*)(L0 + MISC_OFF) + 8); }
    const int lo = args_.ph_lo, hi = args_.ph_hi;
    for (int ph = lo; ph < hi; ++ph) {
#if defined(PROBE_S0)
        const int reps = (ph != N_PHASES - 1 && (ph % 9 == PROBE_S0 || ph % 9 == PROBE_S1)) ? 2 : 1;
#else
        const int reps = 1;
#endif
        for (int rep = 0; rep < reps; ++rep) {
        const __attribute__((address_space(4))) Args* ap = (const __attribute__((address_space(4))) Args*)__builtin_amdgcn_kernarg_segment_ptr();
        asm volatile("" : "+s"(ap));
        const __attribute__((address_space(4))) Args& args = *ap;
        LAS unsigned char* L = (LAS unsigned char*)lds;
        const int tid = ltid(), lane = tid & 63, wave = __builtin_amdgcn_readfirstlane(tid >> 6);
        const int G = gridDim.x, bid = blockIdx.x;
        const int vcu = (G % 8 == 0) ? (bid % 8) * (G / 8) + bid / 8 : bid;
        unsigned char* ws = args.ws;
        const int gw = vcu * NWAVES + wave, NGW = G * NWAVES;
        const int l = ph / 9, s = ph % 9;
        if (ph == N_PHASES - 1) {
            const float* gfin = args.in[14]; float* const out = args.out;
            for (int m = gw; m < M; m += NGW) { GAS f32x4* xr = (GAS f32x4*)(out + (size_t)m * D) + lane; f32x4 v[4]; float sq = 0.f;
#pragma unroll
                for (int j = 0; j < 4; ++j) { v[j] = xr[64 * j]; sq += (v[j].x * v[j].x + v[j].y * v[j].y) + (v[j].z * v[j].z + v[j].w * v[j].w); }
                const float rs = 1.0f / sqrtf(wave_sum(sq) * (1.0f / D) + 1e-6f);
#pragma unroll
                for (int j = 0; j < 4; ++j) { const f32x4 gg = *((const f32x4*)gfin + 64 * j + lane); xr[64 * j] = v[j] * rs * gg; } }
        } else if (s == 0) {
            const float* w13a = args.in[2] + (size_t)l * D * 2 * FF; const float* w2a = args.in[3] + (size_t)l * FF * D; const float* win = args.in[5] + (size_t)l * D * NIN;
            const float* wc = args.in[8] + (size_t)l * 512 * D; const float* wa = args.in[9] + (size_t)l * 512 * D; const float* wo = args.in[10] + (size_t)l * D * D;
            const float* w13b = args.in[12] + (size_t)l * D * 2 * FF; const float* w2b = args.in[13] + (size_t)l * FF * D;
            const float* g1 = args.in[1] + l * D; const float* gm = args.in[4] + l * D; const float* g2 = args.in[11] + l * D;
            constexpr int I13 = (D / 64) * (2 * FF / 64), I2 = (FF / 64) * (D / 64), IIN = (D / 64) * (NIN / 64), ICO = (512 / 64) * (D / 64), IO = (D / 64) * (D / 64);
            constexpr int NITEMS = 2 * I13 + 2 * I2 + IIN + 2 * ICO + IO;
            for (int it = gw; it < NITEMS; it += NGW) {
                int r = it;
                if (r < I13) { transpose_item(w13a, D, 2 * FF, (bf16*)(ws + WS_W13A), g1, 1, r, lane); continue; } r -= I13;
                if (r < I13) { transpose_item(w13b, D, 2 * FF, (bf16*)(ws + WS_W13B), g2, 1, r, lane); continue; } r -= I13;
                if (r < IIN) { transpose_item(win, D, NIN, (bf16*)(ws + WS_WIN), gm, 2, r, lane); continue; } r -= IIN;
                if (r < I2) { transpose_item(w2a, FF, D, (bf16*)(ws + WS_W2A), nullptr, 0, r, lane); continue; } r -= I2;
                if (r < I2) { transpose_item(w2b, FF, D, (bf16*)(ws + WS_W2B), nullptr, 0, r, lane); continue; } r -= I2;
                if (r < IO) { transpose_item(wo, D, D, (bf16*)(ws + WS_WO), nullptr, 0, r, lane); continue; } r -= IO;
                if (r < ICO) { transpose_item(wc, 512, D, (bf16*)(ws + WS_WC), nullptr, 0, r, lane); continue; } r -= ICO;
                transpose_item(wa, 512, D, (bf16*)(ws + WS_WA), nullptr, 0, r, lane);
            }
            if (l == 0) {
                const float* x = args.in[0]; bf16* const XB = (bf16*)(ws + WS_XB); float* const ssq = (float*)(ws + WS_SSQ);
                for (int m = 2 * gw; m < M; m += 2 * NGW) { const GAS f32x4* xr = (const GAS f32x4*)(x + (size_t)m * D) + lane; f32x4 v[8];
#pragma unroll
                    for (int j = 0; j < 8; ++j) v[j] = xr[64 * j];
#pragma unroll
                    for (int h2 = 0; h2 < 2; ++h2) { float sq = 0.f;
#pragma unroll
                        for (int j = 0; j < 4; ++j) { const f32x4 w = v[4 * h2 + j]; sq += (w.x * w.x + w.y * w.y) + (w.z * w.z + w.w * w.w); }
                        sq = wave_sum(sq);
                        GAS unsigned long long* o8 = (GAS unsigned long long*)(XB + (size_t)(m + h2) * D) + lane;
#pragma unroll
                        for (int j = 0; j < 4; ++j) { const f32x4 w = v[4 * h2 + j]; o8[64 * j] = (unsigned long long)pk2(w.x, w.y) | ((unsigned long long)pk2(w.z, w.w) << 32); }
                        if (lane < 16) ssq[(size_t)(m + h2) * 16 + lane] = lane == 0 ? sq : 0.f; } }
            }
        } else if (s == 4) {
            const float* cw = args.in[7] + (size_t)l * 3 * 512;
            bf16* const CB = (bf16*)(ws + WS_CB); bf16* const U = (bf16*)(ws + WS_U); bf16* const Qb = (bf16*)(ws + WS_Q); bf16* const Kb = (bf16*)(ws + WS_K); bf16* const Vb = (bf16*)(ws + WS_V); bf16* const YA = (bf16*)(ws + WS_YA);
            if (rep == 0) for (int i = bid * (NWAVES * 64) + tid; i < M * 64; i += G * NWAVES * 64) { const int row = i >> 6, c0 = (i & 63) * 8, t = row & (SEQ - 1);
                const pg8::u32x4e zero4 = {0u, 0u, 0u, 0u};
                const pg8::u32x4e cbv = *(const pg8::u32x4e*)(CB + (size_t)row * 512 + c0), u2 = *(const pg8::u32x4e*)(U + (size_t)row * 512 + c0);
                const pg8::u32x4e u1 = t >= 1 ? *(const pg8::u32x4e*)(U + (size_t)(row - 1) * 512 + c0) : zero4, u0 = t >= 2 ? *(const pg8::u32x4e*)(U + (size_t)(row - 2) * 512 + c0) : zero4;
                f32x4 cb0, cb1, a0, a1, b0, b1, c0v, c1v; pg8::unpack8(cbv, cb0, cb1); pg8::unpack8(u0, a0, a1); pg8::unpack8(u1, b0, b1); pg8::unpack8(u2, c0v, c1v);
                const f32x4 w00 = *(const f32x4*)(cw + c0), w01 = *(const f32x4*)(cw + c0 + 4), w10 = *(const f32x4*)(cw + 512 + c0), w11 = *(const f32x4*)(cw + 512 + c0 + 4), w20 = *(const f32x4*)(cw + 1024 + c0), w21 = *(const f32x4*)(cw + 1024 + c0 + 4);
                const f32x4 y0 = cb0 * (w00 * a0 + w10 * b0 + w20 * c0v), y1 = cb1 * (w01 * a1 + w11 * b1 + w21 * c1v);
                *(pg8::u32x4e*)(CB + (size_t)row * 512 + c0) = pg8::pack8(y0, y1); }
            __syncthreads();
            for (int p = vcu; p < 256; p += G) { const int bh = p >> 2, sI = p & 3;
                sba::attn_unit(bh >> 3, bh & 7, 7 - sI, Qb, Kb, Vb, YA, L);
                sba::attn_unit(bh >> 3, bh & 7, sI, Qb, Kb, Vb, YA, L); }
        } else {
            const int ncall = (s == 5) ? 2 : 1;
            for (int c = 0; c < ncall; ++c) {
                pg8::Gemm g{}; pg8::EpiAll E{};
                E.ws = ws; E.outf = args.out; E.base = args.out; E.alpha = 0.5f; E.bgate = args.in[6] + (size_t)l * 2048;
                g.M = M;
                if (s == 1)      { g.A = (const bf16*)(ws + WS_XB);  g.Bt = (const bf16*)(ws + WS_W13A); g.N = 2 * FF; g.K = D;  E.mode = pg8::EP_SWIGLU; }
                else if (s == 2) { g.A = (const bf16*)(ws + WS_ACT); g.Bt = (const bf16*)(ws + WS_W2A);  g.N = D;      g.K = FF; E.mode = pg8::EP_RESID; if (l == 0) E.base = args.in[0]; }
                else if (s == 3) { g.A = (const bf16*)(ws + WS_XB);  g.Bt = (const bf16*)(ws + WS_WIN);  g.N = NIN;    g.K = D;  E.mode = pg8::EP_WIN; }
                else if (s == 5) { if (c == 0) { g.A = (const bf16*)(ws + WS_YA); g.Bt = (const bf16*)(ws + WS_WA); E.mode = pg8::EP_MERGE1; } else { g.A = (const bf16*)(ws + WS_CB); g.Bt = (const bf16*)(ws + WS_WC); E.mode = pg8::EP_MERGE2; } g.N = D; g.K = 512; }
                else if (s == 6) { g.A = (const bf16*)(ws + WS_MG);  g.Bt = (const bf16*)(ws + WS_WO);   g.N = D;      g.K = D;  E.mode = pg8::EP_RESID; E.alpha = 1.0f; }
                else if (s == 7) { g.A = (const bf16*)(ws + WS_XB);  g.Bt = (const bf16*)(ws + WS_W13B); g.N = 2 * FF; g.K = D;  E.mode = pg8::EP_SWIGLU; }
                else             { g.A = (const bf16*)(ws + WS_ACT); g.Bt = (const bf16*)(ws + WS_W2B);  g.N = D;      g.K = FF; E.mode = pg8::EP_RESID; }
                pg8::StaticOrder S; S.init(M, g.N, G, bid);
                pg8::gemm_phase<pg8::EpiAll, pg8::StaticOrder, true, true>(L, g, S, E);
            }
        }
        }
        if (ph + 1 < hi) {
            if (args_.coop == 2) { __threadfence(); cg::this_grid().sync(); }
            else { XcdBarrier bar; bar.bar = (unsigned*)(args_.ws + WS_CTL) + CW_BAR; bar.x = xb_xcc_id(); bar.st = (volatile LAS unsigned*)((LAS unsigned char*)lds + MISC_OFF) + 8; xcd_barrier(bar); }
        }
    }
}

extern "C" void kernel_launch(void* const* d_in, const int* in_sizes, int n_in, void* d_out, int out_size, void* d_ws, size_t ws_size, hipStream_t stream) {
    static int grid = 0;
    if (grid == 0) {
        if (n_in != 15 || in_sizes[0] != M * D || out_size != M * D || ws_size < WS_END) { fprintf(stderr, "kernel_launch: unexpected shapes (n_in %d, in0 %d, out %d, ws %zu); nothing launched\n", n_in, n_in > 0 ? in_sizes[0] : -1, out_size, ws_size); grid = -1; return; }
        int dev = 0, cus = 0, per_cu = 0;
        if (hipGetDevice(&dev) != hipSuccess || hipDeviceGetAttribute(&cus, hipDeviceAttributeMultiprocessorCount, dev) != hipSuccess) { grid = -1; return; }
        if (hipFuncSetAttribute((const void*)fwd_kernel, hipFuncAttributeMaxDynamicSharedMemorySize, LDS_BYTES) != hipSuccess) { fprintf(stderr, "kernel_launch: hipFuncSetAttribute failed\n"); grid = -1; return; }
        if (hipOccupancyMaxActiveBlocksPerMultiprocessor(&per_cu, (const void*)fwd_kernel, NWAVES * 64, LDS_BYTES) != hipSuccess || per_cu < 1) { fprintf(stderr, "kernel_launch: occupancy query says %d blocks per CU; nothing launched\n", per_cu); (void)hipGetLastError(); grid = -1; return; }
        grid = cus < 256 ? cus : 256;
    }
    if (grid < 0) return;
    if (hipMemsetAsync((char*)d_ws + WS_CTL, 0, CTL_ZERO_BYTES, stream) != hipSuccess) { fprintf(stderr, "kernel_launch: hipMemsetAsync failed\n"); return; }
    Args a{};
    for (int i = 0; i < 15; ++i) a.in[i] = (const float*)d_in[i];
    a.out = (float*)d_out; a.ws = (unsigned char*)d_ws;
#if MK_PER_PHASE
    for (int ph = 0; ph < N_PHASES; ++ph) { a.ph_lo = ph; a.ph_hi = ph + 1; a.coop = 0;
        hipLaunchKernelGGL(fwd_kernel, dim3(grid), dim3(NWAVES * 64), LDS_BYTES, stream, a); }
#else
    a.ph_lo = 0; a.ph_hi = N_PHASES; a.coop = 1;
    void* kargs[] = {&a};
    const hipError_t e = hipLaunchCooperativeKernel((const void*)fwd_kernel, dim3(grid), dim3(NWAVES * 64), kargs, LDS_BYTES, stream);
    if (e != hipSuccess) fprintf(stderr, "kernel_launch: cooperative launch failed: %s (grid %d)\n", hipGetErrorString(e), grid);
#endif
}
```

```cpp
#include <hip/hip_runtime.h>
#include <hip/hip_cooperative_groups.h>
#include <cstdio>
#include <cstdint>
namespace cg = cooperative_groups;
__device__ __forceinline__ int ltid() { int t = threadIdx.x; asm volatile("" : "+v"(t)); return t; }
namespace pg8 {
#define PG8_LAS __attribute__((address_space(3)))
typedef unsigned short bf16_t;
typedef short bf16x8 __attribute__((ext_vector_type(8)));
typedef float f32x4 __attribute__((ext_vector_type(4)));
typedef unsigned u32x4 __attribute__((ext_vector_type(4)));
constexpr int BM = 256, BK = 64, HALF = 128, HTB = HALF * BK * 2  , STAGE_BYTES = 8 * HTB, NXCD = 8, WGM = 8;

__host__ __device__ __forceinline__ int lds_byte(int r, int c) { const int st = (r >> 4) * 2 + (c >> 5), rr = r & 15, cc = c & 31, ob = rr * 64 + cc * 2; return st * 1024 + (ob ^ (((ob >> 9) & 1) << 5)); }
__host__ __device__ __forceinline__ void stage_rc(int b, int& R, int& C) { const int st = b / 1024, sb = b % 1024, swz = sb ^ (((sb >> 9) & 1) << 5); R = (st >> 1) * 16 + swz / 64; C = (st & 1) * 32 + (swz % 64) / 2; }
__host__ __device__ __forceinline__ int perm32(int rho) { const int n = rho >> 4, i = rho & 15; return 8 * (i >> 2) + 4 * n + (i & 3); }

struct Unit { int pm, pn; };
struct Gemm { const bf16_t* A; const bf16_t* Bt; int M, N, K; };

struct StaticOrder {
    int nM, nN, nwg, G, c;
    __host__ __device__ void init(int M, int N, int G_, int c_) { nM = M / BM; nN = N / BM; nwg = nM * nN; G = G_; c = c_; }
    __host__ __device__ bool next(int i, Unit& u) const {
        const long L = (long)i * G + c; if (L >= nwg) return false;
        int wgid = (int)L; { const int q = nwg / NXCD, r = nwg % NXCD, xcd = wgid % NXCD, off = wgid / NXCD; wgid = (xcd < r ? xcd * (q + 1) : r * (q + 1) + (xcd - r) * q) + off; }
        const int nig = WGM * nN, gid = wgid / nig, fm = gid * WGM, gsz = (nM - fm) < WGM ? (nM - fm) : WGM;
        u.pm = fm + ((wgid % nig) % gsz); u.pn = (wgid % nig) / gsz; return true;
    }
    __device__ __forceinline__ void a_ready(const Unit&) const {}
    __device__ __forceinline__ void done(const Unit&) const {}
};

__device__ __forceinline__ unsigned cvt_pk_bf16(float lo, float hi) { unsigned r; asm volatile("v_cvt_pk_bf16_f32 %0, %1, %2" : "=v"(r) : "v"(lo), "v"(hi)); return r; }
typedef float f32x2 __attribute__((ext_vector_type(2)));

typedef unsigned u32x4e __attribute__((ext_vector_type(4)));
constexpr float LOG2E = 1.4426950408889634f;
constexpr float QSCALE = 0.125f * LOG2E;
__device__ __forceinline__ float rowscale(const float* ssq, int row) {
    const f32x4* p = (const f32x4*)(ssq + (size_t)row * 16);
    const f32x4 s = (p[0] + p[1]) + (p[2] + p[3]);
    return __builtin_amdgcn_rsqf(((s[0] + s[1]) + (s[2] + s[3])) * (1.0f / 1024.0f) + 1e-6f);
}
__device__ __forceinline__ float sigmoid_f(float x) { return __builtin_amdgcn_rcpf(1.0f + __builtin_amdgcn_exp2f(-x * LOG2E)); }
__device__ __forceinline__ u32x4e pack8(const f32x4 a, const f32x4 b) { u32x4e w; w.x = cvt_pk_bf16(a[0], a[1]); w.y = cvt_pk_bf16(a[2], a[3]); w.z = cvt_pk_bf16(b[0], b[1]); w.w = cvt_pk_bf16(b[2], b[3]); return w; }
__device__ __forceinline__ void unpack8(const u32x4e w, f32x4& a, f32x4& b) {
    a[0] = __uint_as_float(w.x << 16); a[1] = __uint_as_float(w.x & 0xffff0000u); a[2] = __uint_as_float(w.y << 16); a[3] = __uint_as_float(w.y & 0xffff0000u);
    b[0] = __uint_as_float(w.z << 16); b[1] = __uint_as_float(w.z & 0xffff0000u); b[2] = __uint_as_float(w.w << 16); b[3] = __uint_as_float(w.w & 0xffff0000u);
}
constexpr size_t EMiB = 1u << 20;
constexpr size_t EWS_SSQ = 1 * EMiB, EWS_XB = 49 * EMiB, EWS_ACT = 81 * EMiB, EWS_CB = 81 * EMiB, EWS_U = 97 * EMiB, EWS_Q = 113 * EMiB, EWS_K = 129 * EMiB, EWS_V = 145 * EMiB, EWS_G = 161 * EMiB, EWS_MG = 129 * EMiB;
enum { EP_SWIGLU = 0, EP_RESID = 1, EP_WIN = 2, EP_MERGE1 = 3, EP_MERGE2 = 4 };
struct EpiAll {
    static constexpr bool PERM = true, AFTER_DRAIN = false;
    int mode; float alpha;
    unsigned char* ws;
    float* outf;
    const float* base;
    const float* bgate;
    __device__ __forceinline__ void operator()(const f32x4 (&acc)[2][2][4][2], const Unit& u, int wr, int wc, int fr, int fq) const {
        const int row0 = u.pm * BM + wr * 64 + fr, lc = wc * 32 + 8 * fq, pn = u.pn;
        const float* ssq = (const float*)(ws + EWS_SSQ); float* ssq_out = (float*)(ws + EWS_SSQ);
        bf16_t* act = (bf16_t*)(ws + EWS_ACT); bf16_t* xb = (bf16_t*)(ws + EWS_XB);
        bf16_t* cb = (bf16_t*)(ws + EWS_CB); bf16_t* uu = (bf16_t*)(ws + EWS_U); bf16_t* q = (bf16_t*)(ws + EWS_Q); bf16_t* k = (bf16_t*)(ws + EWS_K); bf16_t* v = (bf16_t*)(ws + EWS_V);
        bf16_t* g = (bf16_t*)(ws + EWS_G); bf16_t* mg = (bf16_t*)(ws + EWS_MG);
        if (mode == EP_SWIGLU) {
#pragma unroll
            for (int ai = 0; ai < 2; ++ai)
#pragma unroll
                for (int m = 0; m < 4; ++m) { const int row = row0 + ai * HALF + m * 16; const float rs = rowscale(ssq, row);
                    f32x4 o[2];
#pragma unroll
                    for (int n = 0; n < 2; ++n) { const f32x4 a = acc[ai][0][m][n] * rs, b = acc[ai][1][m][n] * rs;
#pragma unroll
                        for (int e = 0; e < 4; ++e) o[n][e] = a[e] * sigmoid_f(a[e]) * b[e]; }
                    *(u32x4e*)(act + (size_t)row * 2816 + pn * 128 + lc) = pack8(o[0], o[1]); }
        } else if (mode == EP_RESID) {
#pragma unroll
            for (int ai = 0; ai < 2; ++ai)
#pragma unroll
                for (int m = 0; m < 4; ++m) { const int row = row0 + ai * HALF + m * 16; float s = 0.f;
#pragma unroll
                    for (int bj = 0; bj < 2; ++bj) { const size_t off = (size_t)row * 1024 + pn * BM + bj * HALF + lc;
                        const f32x4 x0 = *(const f32x4*)(base + off), x1 = *(const f32x4*)(base + off + 4);
                        const f32x4 y0 = x0 + acc[ai][bj][m][0] * alpha, y1 = x1 + acc[ai][bj][m][1] * alpha;
                        *(f32x4*)(outf + off) = y0; *(f32x4*)(outf + off + 4) = y1; *(u32x4e*)(xb + off) = pack8(y0, y1);
                        s += (y0[0] * y0[0] + y0[1] * y0[1]) + (y0[2] * y0[2] + y0[3] * y0[3]) + (y1[0] * y1[0] + y1[1] * y1[1]) + (y1[2] * y1[2] + y1[3] * y1[3]); }
                    s += __shfl_xor(s, 16); s += __shfl_xor(s, 32);
                    if (fq == 0) ssq_out[(size_t)row * 16 + pn * 4 + wc] = s; }
        } else if (mode == EP_WIN) {
#pragma unroll
            for (int ai = 0; ai < 2; ++ai)
#pragma unroll
                for (int m = 0; m < 4; ++m) { const int row = row0 + ai * HALF + m * 16; const float rs = rowscale(ssq, row);
                    if (pn >= 2 && pn < 6) {
                        const float rs2 = rs * rs;
                        const f32x4 o0 = acc[ai][0][m][0] * acc[ai][1][m][0] * rs2, o1 = acc[ai][0][m][1] * acc[ai][1][m][1] * rs2;
                        *(u32x4e*)(uu + (size_t)row * 512 + (pn - 2) * 128 + lc) = pack8(o0, o1);
                    } else {
#pragma unroll
                        for (int bj = 0; bj < 2; ++bj) { const int col = bj * HALF + lc;
                            if (pn < 2) { *(u32x4e*)(cb + (size_t)row * 512 + pn * BM + col) = pack8(acc[ai][bj][m][0] * rs, acc[ai][bj][m][1] * rs); }
                            else if (pn < 12) { const int t = (pn - 6) >> 1; bf16_t* dst = t == 0 ? q : (t == 1 ? k : v); const float sc = t == 0 ? rs * QSCALE : rs;
                                *(u32x4e*)(dst + (size_t)row * 512 + ((pn - 6) & 1) * BM + col) = pack8(acc[ai][bj][m][0] * sc, acc[ai][bj][m][1] * sc); }
                            else { const int gc = (pn - 12) * BM + col; const f32x4 b0 = *(const f32x4*)(bgate + gc), b1 = *(const f32x4*)(bgate + gc + 4);
                                const f32x4 z0 = acc[ai][bj][m][0] * rs + b0, z1 = acc[ai][bj][m][1] * rs + b1; f32x4 o0, o1;
#pragma unroll
                                for (int e = 0; e < 4; ++e) { o0[e] = sigmoid_f(z0[e]); o1[e] = sigmoid_f(z1[e]); }
                                *(u32x4e*)(g + (size_t)row * 2048 + gc) = pack8(o0, o1); } }
                    } }
        } else {
#pragma unroll
            for (int ai = 0; ai < 2; ++ai)
#pragma unroll
                for (int m = 0; m < 4; ++m) { const int row = row0 + ai * HALF + m * 16;
#pragma unroll
                    for (int bj = 0; bj < 2; ++bj) { const int col = pn * BM + bj * HALF + lc; bf16_t* ga = g + (size_t)row * 2048 + 1024 + col;
                        if (mode == EP_MERGE1) { f32x4 g0, g1; unpack8(*(const u32x4e*)ga, g0, g1); *(u32x4e*)ga = pack8(g0 * acc[ai][bj][m][0], g1 * acc[ai][bj][m][1]); }
                        else { f32x4 g0, g1, m0, m1; unpack8(*(const u32x4e*)(g + (size_t)row * 2048 + col), g0, g1); unpack8(*(const u32x4e*)ga, m0, m1);
                            *(u32x4e*)(mg + (size_t)row * 1024 + col) = pack8(m0 + g0 * acc[ai][bj][m][0], m1 + g1 * acc[ai][bj][m][1]); } } }
        }
    }
};
template <class Epi, class Sched, bool ALIGN_EPI = false, bool SP2 = false>
__device__ __forceinline__ void gemm_phase(PG8_LAS unsigned char* lds, const Gemm g, const Sched& S, const Epi& E) {
    const int tid = ltid(), wid = __builtin_amdgcn_readfirstlane(tid >> 6), lane = tid & 63, wr = wid >> 2, wc = wid & 3, fr = lane & 15, fq = lane >> 4;
    const int K = g.K, nt = K / BK;
    unsigned voffA[2], voffB[2];
#pragma unroll
    for (int i = 0; i < 2; ++i) { int R, C; stage_rc(tid * 16 + i * 8192, R, C); const int Rb = Epi::PERM ? ((R & ~31) + perm32(R & 31)) : R;
        voffA[i] = (unsigned)(R * K + C) * 2u; voffB[i] = (unsigned)(Rb * K + C) * 2u; }
    const size_t kstep = (size_t)(BK * 2);
    const size_t hstep = (size_t)HALF * K * 2;
    const size_t tstep = 2 * hstep;
    const unsigned ldsw = (unsigned)wid * 1024u;
    const int aoff = lds_byte(wr * 64 + fr, fq * 8), boff = lds_byte(wc * 32 + fr, fq * 8);
#define PG8_SA(b, h) (((b) * 2 + (h)) * HTB)
#define PG8_SB(b, h) ((4 + (b) * 2 + (h)) * HTB)
#define PG8_STAGE(bufoff, gbase, voff) do { _Pragma("unroll") for (int _i = 0; _i < 2; ++_i) \
        __builtin_amdgcn_global_load_lds((const unsigned*)((const char*)(gbase) + (voff)[_i]), (PG8_LAS unsigned*)(lds + (bufoff) + ldsw + _i * 8192), 16, 0, 0); } while (0)
#define PG8_LDA(dst, b, h) do { _Pragma("unroll") for (int m = 0; m < 4; ++m) _Pragma("unroll") for (int k = 0; k < 2; ++k) dst[m][k] = *(const PG8_LAS bf16x8*)(lds + PG8_SA(b, h) + aoff + m * 2048 + k * 1024); } while (0)
#define PG8_LDB(dst, b, h) do { _Pragma("unroll") for (int n = 0; n < 2; ++n) _Pragma("unroll") for (int k = 0; k < 2; ++k) dst[n][k] = *(const PG8_LAS bf16x8*)(lds + PG8_SB(b, h) + boff + n * 2048 + k * 1024); } while (0)
#define PG8_MMA(ai, bj, At, Bt) do { __builtin_amdgcn_s_setprio(1); _Pragma("unroll") for (int m = 0; m < 4; ++m) _Pragma("unroll") for (int n = 0; n < 2; ++n) _Pragma("unroll") for (int k = 0; k < 2; ++k) \
        acc[ai][bj][m][n] = __builtin_amdgcn_mfma_f32_16x16x32_bf16(Bt[n][k], At[m][k], acc[ai][bj][m][n], 0, 0, 0); __builtin_amdgcn_s_setprio(0); } while (0)
#define PG8_WAIT_V(n) asm volatile("s_waitcnt vmcnt(" #n ")" ::: "memory")
#define PG8_WAIT_L(n) asm volatile("s_waitcnt lgkmcnt(" #n ")" ::: "memory")
#define PG8_BAR __builtin_amdgcn_s_barrier()
#define PG8_SCHED __builtin_amdgcn_sched_barrier(0)
    Unit cur, nxt; int ui = 0;
    if (!S.next(0, cur)) return;
    f32x4 acc[2][2][4][2];
#pragma unroll
    for (int a = 0; a < 2; ++a)
#pragma unroll
        for (int b = 0; b < 2; ++b)
#pragma unroll
            for (int m = 0; m < 4; ++m)
#pragma unroll
                for (int n = 0; n < 2; ++n) acc[a][b][m][n] = (f32x4){0.f, 0.f, 0.f, 0.f};
    bf16x8 At[4][2], B0[2][2], B1[2][2];
    const char* cA = (const char*)g.A + (size_t)cur.pm * tstep; const char* cB = (const char*)g.Bt + (size_t)cur.pn * tstep;
    S.a_ready(cur);
    if constexpr (SP2) {
        PG8_STAGE(PG8_SB(0, 0), cB, voffB); PG8_STAGE(PG8_SB(0, 1), cB + hstep, voffB); PG8_STAGE(PG8_SA(0, 0), cA, voffA); PG8_STAGE(PG8_SA(0, 1), cA + hstep, voffA);
        if (wr == 1) PG8_BAR;
        PG8_WAIT_V(2); PG8_BAR;
        PG8_STAGE(PG8_SB(1, 0), cB + kstep, voffB); PG8_STAGE(PG8_SA(1, 0), cA + kstep, voffA); PG8_STAGE(PG8_SB(1, 1), cB + hstep + kstep, voffB);
        PG8_WAIT_V(6); PG8_BAR;
    } else {
        PG8_STAGE(PG8_SB(0, 0), cB, voffB); PG8_STAGE(PG8_SA(0, 0), cA, voffA); PG8_STAGE(PG8_SB(0, 1), cB + hstep, voffB); PG8_STAGE(PG8_SA(0, 1), cA + hstep, voffA);
        if (wr == 1) PG8_BAR;
        PG8_WAIT_V(4); PG8_BAR;
        PG8_STAGE(PG8_SB(1, 0), cB + kstep, voffB); PG8_STAGE(PG8_SA(1, 0), cA + kstep, voffA); PG8_STAGE(PG8_SB(1, 1), cB + hstep + kstep, voffB);
        PG8_WAIT_V(6); PG8_BAR;
    }
    for (;;) {
        const bool has_next = S.next(ui + 1, nxt);
        const char* nA = has_next ? (const char*)g.A + (size_t)nxt.pm * tstep : cA; const char* nB = has_next ? (const char*)g.Bt + (size_t)nxt.pn * tstep : cB;
        for (int t = 0; t < nt; t += 2) {
            const bool last = (t == nt - 2);
            const char* a1 = cA + (size_t)(t + 1) * kstep;
            const char* a2 = last ? nA : cA + (size_t)(t + 2) * kstep; const char* b2 = last ? nB : cB + (size_t)(t + 2) * kstep;
            const char* a3 = a2 + kstep; const char* b3 = b2 + kstep;
            if (last && has_next) S.a_ready(nxt);
            if constexpr (SP2) {
            PG8_LDB(B0, 0, 0); PG8_LDB(B1, 0, 1); PG8_SCHED; PG8_LDA(At, 0, 0); PG8_STAGE(PG8_SA(1, 1), a1 + hstep, voffA);
            PG8_WAIT_V(8); PG8_WAIT_L(0); PG8_BAR; PG8_MMA(0, 0, At, B0); PG8_MMA(0, 1, At, B1); PG8_BAR; PG8_SCHED;
            PG8_LDA(At, 0, 1); PG8_STAGE(PG8_SB(0, 0), b2, voffB); PG8_STAGE(PG8_SB(0, 1), b2 + hstep, voffB); PG8_STAGE(PG8_SA(0, 0), a2, voffA);
            PG8_WAIT_V(8); PG8_WAIT_L(0); PG8_BAR; PG8_MMA(1, 0, At, B0); PG8_MMA(1, 1, At, B1); PG8_BAR; PG8_SCHED;
            PG8_LDB(B0, 1, 0); PG8_LDB(B1, 1, 1); PG8_SCHED; PG8_LDA(At, 1, 0); PG8_STAGE(PG8_SA(0, 1), a2 + hstep, voffA);
            PG8_WAIT_V(8); PG8_WAIT_L(0); PG8_BAR; PG8_MMA(0, 0, At, B0); PG8_MMA(0, 1, At, B1); PG8_BAR; PG8_SCHED;
            PG8_LDA(At, 1, 1); PG8_STAGE(PG8_SB(1, 0), b3, voffB); PG8_STAGE(PG8_SB(1, 1), b3 + hstep, voffB); PG8_STAGE(PG8_SA(1, 0), a3, voffA);
            PG8_WAIT_V(8); PG8_WAIT_L(0); PG8_BAR; PG8_MMA(1, 0, At, B0); PG8_MMA(1, 1, At, B1); PG8_BAR; PG8_SCHED;
            } else {
            PG8_LDB(B0, 0, 0); PG8_SCHED; PG8_LDA(At, 0, 0); PG8_STAGE(PG8_SA(1, 1), a1 + hstep, voffA);
            PG8_WAIT_L(8); PG8_BAR; PG8_WAIT_L(0); PG8_MMA(0, 0, At, B0); PG8_BAR; PG8_SCHED;
            PG8_LDB(B1, 0, 1); PG8_STAGE(PG8_SB(0, 0), b2, voffB);
            PG8_BAR; PG8_WAIT_L(0); PG8_MMA(0, 1, At, B1); PG8_BAR;
            PG8_LDA(At, 0, 1); PG8_STAGE(PG8_SA(0, 0), a2, voffA);
            PG8_BAR; PG8_WAIT_L(0); PG8_MMA(1, 0, At, B0); PG8_BAR; PG8_SCHED;
            PG8_STAGE(PG8_SB(0, 1), b2 + hstep, voffB);
            PG8_WAIT_V(6); PG8_BAR; PG8_MMA(1, 1, At, B1); PG8_BAR;
            PG8_LDB(B0, 1, 0); PG8_SCHED; PG8_LDA(At, 1, 0); PG8_STAGE(PG8_SA(0, 1), a2 + hstep, voffA);
            PG8_WAIT_L(8); PG8_BAR; PG8_WAIT_L(0); PG8_MMA(0, 0, At, B0); PG8_BAR; PG8_SCHED;
            PG8_LDB(B1, 1, 1); PG8_STAGE(PG8_SB(1, 0), b3, voffB);
            PG8_BAR; PG8_WAIT_L(0); PG8_MMA(0, 1, At, B1); PG8_BAR;
            PG8_LDA(At, 1, 1); PG8_STAGE(PG8_SA(1, 0), a3, voffA);
            PG8_BAR; PG8_WAIT_L(0); PG8_MMA(1, 0, At, B0); PG8_BAR; PG8_SCHED;
            PG8_STAGE(PG8_SB(1, 1), b3 + hstep, voffB);
            PG8_WAIT_V(6); PG8_BAR; PG8_MMA(1, 1, At, B1); PG8_BAR;
            }
        }
        if constexpr (ALIGN_EPI) { if (wr == 0) PG8_BAR; }
        if constexpr (!Epi::AFTER_DRAIN) { E(acc, cur, wr, wc, fr, fq); S.done(cur); }
        if (!has_next) break;
#pragma unroll
        for (int a = 0; a < 2; ++a)
#pragma unroll
            for (int b = 0; b < 2; ++b)
#pragma unroll
                for (int m = 0; m < 4; ++m)
#pragma unroll
                    for (int n = 0; n < 2; ++n) acc[a][b][m][n] = (f32x4){0.f, 0.f, 0.f, 0.f};
        cur = nxt; cA = nA; cB = nB; ++ui;
        if constexpr (ALIGN_EPI) { if (wr == 1) PG8_BAR; }
    }
    PG8_WAIT_V(0);
    if constexpr (!ALIGN_EPI) { if (wr == 0) PG8_BAR; }
    PG8_BAR;
    if constexpr (Epi::AFTER_DRAIN) { E.fused(acc, cur, wr, wc, fr, fq, lds, wid, lane); S.done(cur); }
#undef PG8_SA
#undef PG8_SB
#undef PG8_STAGE
#undef PG8_LDA
#undef PG8_LDB
#undef PG8_MMA
#undef PG8_WAIT_V
#undef PG8_WAIT_L
#undef PG8_BAR
#undef PG8_SCHED
}
}
#define GAS __attribute__((address_space(1)))
#define LAS __attribute__((address_space(3)))
typedef unsigned short bf16;
typedef unsigned v4u __attribute__((ext_vector_type(4)));
typedef float f32x4 __attribute__((ext_vector_type(4)));
typedef short bf16x8 __attribute__((ext_vector_type(8)));
typedef GAS unsigned gu32;
typedef GAS unsigned long long gu64;
#define RLX_AGENT __ATOMIC_RELAXED, __HIP_MEMORY_SCOPE_AGENT
#define LDS_WAIT() asm volatile("s_waitcnt lgkmcnt(0)" ::: "memory")
#define VM_WAIT() asm volatile("s_waitcnt vmcnt(0)" ::: "memory")
__device__ __forceinline__ unsigned long long rt() { return __builtin_amdgcn_s_memrealtime(); }
__device__ __forceinline__ unsigned f2bf(float f) { unsigned u = __builtin_bit_cast(unsigned, f); return (u + 0x7fffu + ((u >> 16) & 1u)) >> 16; }
__device__ __forceinline__ unsigned pk2(float lo, float hi) { return f2bf(lo) | (f2bf(hi) << 16); }
#define XB_TMO      128
#define XB_XCNT(j)  (256  + 64 * (j))
#define XB_XSUB(j)  (1280 + 64 * (j))
#define XB_XGEN(j)  (2304 + 64 * (j))
#define XB_TOP      3328
#define XB_TOPGEN   3392
#define XCD_BAR_WORDS 3456
#define XB_SPIN_CAP (1u << 18)

__device__ __forceinline__ unsigned xb_ld(unsigned* p)              { return __hip_atomic_load(p, __ATOMIC_RELAXED, __HIP_MEMORY_SCOPE_AGENT); }
__device__ __forceinline__ unsigned xb_add(unsigned* p, unsigned v) { return __hip_atomic_fetch_add(p, v, __ATOMIC_RELAXED, __HIP_MEMORY_SCOPE_AGENT); }
__device__ __forceinline__ unsigned xb_xcc_id() { return (unsigned)__builtin_amdgcn_s_getreg((3 << 11) | 20) & 0xFu; }
#define XB_SPIN(cond, bar) do { unsigned _sp = 0; while (cond) { __builtin_amdgcn_s_sleep(1); \
    if ((++_sp & 255u) == 0u) { if (xb_ld(&(bar)[XB_TMO])) break; if (_sp > XB_SPIN_CAP) { atomicAdd(&(bar)[XB_TMO], 1u); break; } } } } while (0)

struct XcdBarrier {
    unsigned* bar; unsigned x;
    volatile LAS unsigned* st;
};

__device__ __forceinline__ XcdBarrier xcd_barrier_post(unsigned* bar, volatile LAS unsigned* st) {
    XcdBarrier b; b.bar = bar; b.x = xb_xcc_id(); b.st = st;
    if (threadIdx.x == 0) (void)xb_add(&bar[XB_XCNT(b.x)], 1u);
    return b;
}
__device__ __forceinline__ void xcd_barrier_complete(unsigned* bar, unsigned x, unsigned& nloc, unsigned& nx) {
    const unsigned G = gridDim.x * gridDim.y * gridDim.z;
    unsigned sum, cnt, mine, sp = 0u;
    for (;;) {
        sum = 0u; cnt = 0u; mine = 0u;
#pragma unroll
        for (unsigned j = 0; j < 16; ++j) { const unsigned c = xb_ld(&bar[XB_XCNT(j)]); sum += c; cnt += (c > 0u) ? 1u : 0u; mine = (j == x) ? c : mine; }
        if (sum == G) break;
        __builtin_amdgcn_s_sleep(1);
        if ((++sp & 255u) == 0u) { if (xb_ld(&bar[XB_TMO])) break; if (sp > XB_SPIN_CAP) { atomicAdd(&bar[XB_TMO], 1u); break; } }
    }
    nloc = mine > 0u ? mine : 1u; nx = cnt > 0u ? cnt : 1u;
}

__device__ __forceinline__ void xcd_barrier(const XcdBarrier& b) {
    asm volatile("s_waitcnt vmcnt(0)" ::: "memory");
    __syncthreads();
    if (threadIdx.x == 0) {
        unsigned* bar = b.bar;
        __builtin_amdgcn_s_waitcnt(0);
        unsigned nloc = b.st[0], nx = b.st[1];
        if (nloc == 0u) { xcd_barrier_complete(bar, b.x, nloc, nx); b.st[0] = nloc; b.st[1] = nx; }
        const unsigned old = xb_add(&bar[XB_XSUB(b.x)], 1u);
        const unsigned gen = old / nloc;
        if (old + 1u == (gen + 1u) * nloc) {
            __builtin_amdgcn_fence(__ATOMIC_RELEASE, "agent");
            asm volatile("s_waitcnt vmcnt(0)" ::: "memory");
            const unsigned og = xb_add(&bar[XB_TOP], 1u);
            const unsigned tg = og / nx;
            if (og + 1u == (tg + 1u) * nx) xb_add(&bar[XB_TOPGEN], 1u);
            else XB_SPIN(xb_ld(&bar[XB_TOPGEN]) == tg, bar);
            __builtin_amdgcn_fence(__ATOMIC_ACQUIRE, "agent");
            xb_add(&bar[XB_XGEN(b.x)], 1u);
            asm volatile("s_waitcnt vmcnt(0)" ::: "memory");
        } else {
            XB_SPIN(xb_ld(&bar[XB_XGEN(b.x)]) == gen, bar);
            __builtin_amdgcn_fence(__ATOMIC_ACQUIRE, "agent");
            asm volatile("s_waitcnt vmcnt(0)" ::: "memory");
        }
    }
    __syncthreads();
}

namespace sba {
#define LAS3 __attribute__((address_space(3)))
typedef short bf16x8 __attribute__((ext_vector_type(8)));
typedef short s16x4 __attribute__((ext_vector_type(4)));
typedef float f32x16 __attribute__((ext_vector_type(16)));
typedef unsigned u32x4 __attribute__((ext_vector_type(4)));
typedef short v4i16_t __attribute__((ext_vector_type(4)));
typedef unsigned short bf16;
constexpr int SEQ = 2048, PITCH = 512, HD = 64;
__host__ __device__ __forceinline__ constexpr int crow(int r, int hi) { return (r & 3) + 8 * (r >> 2) + 4 * hi; }
__device__ __forceinline__ unsigned cvtpk(float lo, float hi) { unsigned r; asm volatile("v_cvt_pk_bf16_f32 %0, %1, %2" : "=v"(r) : "v"(lo), "v"(hi)); return r; }
__device__ __forceinline__ s16x4 vtr(LAS3 const unsigned char* p) { return __builtin_bit_cast(s16x4, __builtin_amdgcn_ds_read_tr16_b64_v4i16((LAS3 v4i16_t*)p)); }

template <bool PARTIAL>
__device__ __forceinline__ void tile(f32x16 (&o)[2], float& carry, const bf16x8 (&qr)[4], LAS3 const unsigned char* Kslot, LAS3 const unsigned char* Vslot, int lim, int r32, int hi, int lane) {
    f32x16 p0 = {}, p1 = {};
    LAS3 const unsigned char* kb = Kslot + hi * 1024 + r32 * 16;
#pragma unroll
    for (int d0 = 0; d0 < 4; ++d0) {
        const bf16x8 b0 = *(LAS3 const bf16x8*)(kb + d0 * 2048), b1 = *(LAS3 const bf16x8*)(kb + d0 * 2048 + 512);
        p0 = __builtin_amdgcn_mfma_f32_32x32x16_bf16(b0, qr[d0], p0, 0, 0, 0);
        p1 = __builtin_amdgcn_mfma_f32_32x32x16_bf16(b1, qr[d0], p1, 0, 0, 0);
    }
    float kp[32], be[32];
#pragma unroll
    for (int i = 0; i < 32; ++i) {
        const float z = i < 16 ? p0[i] : p1[i - 16];
        const float t = __builtin_amdgcn_exp2f(-__builtin_fabsf(z));
        const float rr = __builtin_amdgcn_rcpf(1.0f + t), uu = t * rr;
        const bool pos = z >= 0.f;
        float b_ = pos ? rr : uu, k_ = pos ? uu : rr;
        if (PARTIAL) { const int c = crow(i & 15, 0) + (i >> 4) * 32; const bool valid = c < lim; b_ = valid ? b_ : 0.f; k_ = valid ? k_ : 1.f; }
        be[i] = b_; kp[i] = k_;
    }
    float E[16];
#pragma unroll
    for (int g = 0; g < 8; ++g) {
        const float gp = (kp[4 * g] * kp[4 * g + 1]) * (kp[4 * g + 2] * kp[4 * g + 3]);
        auto rr = __builtin_amdgcn_permlane32_swap(__float_as_uint(gp), __float_as_uint(gp), false, false);
        E[2 * g] = __uint_as_float(rr[0]); E[2 * g + 1] = __uint_as_float(rr[1]);
    }
    float SP[16]; SP[15] = carry;
#pragma unroll
    for (int k = 14; k >= 0; --k) SP[k] = SP[k + 1] * E[k + 1];
    carry = SP[0] * E[0];
    float a[32];
#pragma unroll
    for (int g = 0; g < 8; ++g) {
        float x = hi ? SP[2 * g + 1] : SP[2 * g];
        a[4 * g + 3] = be[4 * g + 3] * x; x *= kp[4 * g + 3];
        a[4 * g + 2] = be[4 * g + 2] * x; x *= kp[4 * g + 2];
        a[4 * g + 1] = be[4 * g + 1] * x; x *= kp[4 * g + 1];
        a[4 * g] = be[4 * g] * x;
    }
    u32x4 pw[4];
#pragma unroll
    for (int ks = 0; ks < 4; ++ks) { pw[ks].x = cvtpk(a[8 * ks], a[8 * ks + 1]); pw[ks].y = cvtpk(a[8 * ks + 2], a[8 * ks + 3]); pw[ks].z = cvtpk(a[8 * ks + 4], a[8 * ks + 5]); pw[ks].w = cvtpk(a[8 * ks + 6], a[8 * ks + 7]); }
    LAS3 const unsigned char* vb = Vslot + ((lane >> 4) & 1) * 32 + (lane & 3) * 8 + (4 * hi + ((lane & 15) >> 2)) * 64;
#pragma unroll
    for (int d0 = 0; d0 < 2; ++d0)
#pragma unroll
        for (int ks = 0; ks < 4; ++ks) {
            const s16x4 lo = vtr(vb + d0 * 4096 + ks * 1024), h4 = vtr(vb + d0 * 4096 + ks * 1024 + 512);
            const bf16x8 vf = (bf16x8){lo[0], lo[1], lo[2], lo[3], h4[0], h4[1], h4[2], h4[3]};
            o[d0] = __builtin_amdgcn_mfma_f32_32x32x16_bf16(__builtin_bit_cast(bf16x8, pw[ks]), vf, o[d0], 0, 0, 0);
        }
}

__device__ __forceinline__ void attn_unit(int b, int h, int qb, const bf16* Q, const bf16* K, const bf16* V, bf16* O, LAS3 unsigned char* lds) {
    const int tid = ltid(), lane = tid & 63, r32 = lane & 31, hi = lane >> 5; const int wid = __builtin_amdgcn_readfirstlane(tid >> 6);
    const size_t rowbase = (size_t)b * SEQ; const int q0 = qb * 256;
    const int myq = q0 + wid * 32 + r32;
    const bf16* Qw = Q + (rowbase + myq) * PITCH + h * HD;
    bf16x8 qr[4];
#pragma unroll
    for (int d0 = 0; d0 < 4; ++d0) qr[d0] = *(const bf16x8*)(Qw + d0 * 16 + hi * 8);
    const bf16* ksrc = K + (rowbase + lane) * PITCH + h * HD + wid * 8;
    const bf16* vsrc = V + (rowbase + 16 * (wid & 3) + (lane >> 2)) * PITCH + h * HD + (wid >> 2) * 32 + (lane & 3) * 8;
    const int stoff = wid * 1024 + lane * 16;
    const int NT = 4 * qb + 4;
    u32x4 kreg = *(const u32x4*)(ksrc + (size_t)(NT - 1) * 64 * PITCH), vreg = *(const u32x4*)(vsrc + (size_t)(NT - 1) * 64 * PITCH);
    *(LAS3 u32x4*)(lds + stoff) = kreg; *(LAS3 u32x4*)(lds + 16384 + stoff) = vreg;
    __syncthreads();
    f32x16 o[2]; o[0] = f32x16{}; o[1] = f32x16{};
    float carry = 1.f; int buf = 0;
    const int tmin = q0 + wid * 32, tmax = tmin + 31;
    LAS3 unsigned* flags = (LAS3 unsigned*)(lds + 32768);
    bool alive = true; int it = 0;
    for (int j = NT - 1; j >= 0; --j, ++it) {
        if (j > 0) { kreg = *(const u32x4*)(ksrc + (size_t)(j - 1) * 64 * PITCH); vreg = *(const u32x4*)(vsrc + (size_t)(j - 1) * 64 * PITCH); }
        if (alive && 64 * j < tmax) {
            const int lim = myq - 64 * j - 4 * hi;
            if (64 * j + 63 >= tmin) tile<true>(o, carry, qr, lds + buf * 8192, lds + 16384 + buf * 8192, lim, r32, hi, lane);
            else tile<false>(o, carry, qr, lds + buf * 8192, lds + 16384 + buf * 8192, lim, r32, hi, lane);
            alive = __builtin_amdgcn_ballot_w64(carry != 0.f) != 0ull;
        }
        if (lane == 0) flags[(it & 1) * 8 + wid] = alive ? 1u : 0u;
        if (j > 0) { *(LAS3 u32x4*)(lds + (buf ^ 1) * 8192 + stoff) = kreg; *(LAS3 u32x4*)(lds + 16384 + (buf ^ 1) * 8192 + stoff) = vreg; }
        __syncthreads();
        buf ^= 1;
        const u32x4 f0 = *(LAS3 const u32x4*)(flags + (it & 1) * 8), f1 = *(LAS3 const u32x4*)(flags + (it & 1) * 8 + 4);
        if (((f0.x | f0.y) | (f0.z | f0.w) | (f1.x | f1.y) | (f1.z | f1.w)) == 0u) break;
    }
    __syncthreads();
    bf16* Ow = O + (rowbase + q0 + wid * 32) * PITCH + h * HD + r32;
#pragma unroll
    for (int r = 0; r < 16; ++r) { const int orow = crow(r, 0) + 4 * hi;
#pragma unroll
        for (int d0 = 0; d0 < 2; ++d0) Ow[(size_t)orow * PITCH + d0 * 32] = (bf16)(cvtpk(o[d0][r], 0.f) & 0xffffu); }
}
}

constexpr int NWAVES = 8;
constexpr int BATCH = 8, SEQ = 2048, D = 1024, DEPTH = 2, FF = 2816, NIN = 5120;
constexpr int M = BATCH * SEQ;
constexpr int N_PHASES = 9 * DEPTH + 1;
#ifndef MK_PER_PHASE
#define MK_PER_PHASE 0
#endif
constexpr size_t KiB = 1024, MiB = 1u << 20;
constexpr size_t WS_CTL = 0, CTL_ZERO_BYTES = 64 * KiB;
constexpr size_t WS_SSQ = 1 * MiB;
constexpr size_t WS_W13A = 2048 * KiB, WS_W2A = 13312 * KiB, WS_WIN = 18944 * KiB, WS_WC = 29184 * KiB, WS_WA = 30208 * KiB, WS_WO = 31232 * KiB, WS_W13B = 33280 * KiB, WS_W2B = 44544 * KiB;
constexpr size_t WS_XB = 49 * MiB;
constexpr size_t WS_ACT = 81 * MiB;
constexpr size_t WS_CB = 81 * MiB, WS_U = 97 * MiB, WS_Q = 113 * MiB, WS_K = 129 * MiB, WS_V = 145 * MiB, WS_G = 161 * MiB, WS_MG = 129 * MiB, WS_YA = 225 * MiB, WS_END = 241 * MiB;
static_assert(WS_SSQ == pg8::EWS_SSQ && WS_XB == pg8::EWS_XB && WS_ACT == pg8::EWS_ACT && WS_CB == pg8::EWS_CB && WS_U == pg8::EWS_U && WS_Q == pg8::EWS_Q && WS_K == pg8::EWS_K && WS_V == pg8::EWS_V && WS_G == pg8::EWS_G && WS_MG == pg8::EWS_MG, "d_ws map shared with the epilogue");
static_assert(WS_W2B + (size_t)D * FF * 2 <= WS_XB && WS_ACT + (size_t)M * FF * 2 <= 256 * MiB && WS_G + (size_t)M * 2048 * 2 <= WS_YA && WS_END <= 256 * MiB, "d_ws map");
constexpr int CW_BAR = 4096;
constexpr int RING_BYTES = 131072, LDSCTL_OFF = RING_BYTES, MISC_OFF = LDSCTL_OFF + 320, LDS_BYTES = 147456;

__device__ __forceinline__ float wave_sum(float v) {
#pragma unroll
    for (int o = 1; o < 64; o <<= 1) v += __shfl_xor(v, o);
    return v;
}
__device__ __forceinline__ int maprow(int mode, int n) {
    if (mode == 1) { if (n < FF) return 256 * (n / 128) + (n % 128); const int j = n - FF; return 256 * (j / 128) + 128 + (j % 128); }
    if (mode == 2) { if (n < 512 || n >= 1536) return n; const int j = (n - 512) & 511, second = (n >= 1024) ? 128 : 0; return 512 + 256 * (j / 128) + second + (j % 128); }
    return n;
}
__device__ __forceinline__ void transpose_item(const float* W, int K, int N, bf16* WT, const float* gain, int mode, int item, int lane) {
    const int nblk = N / 64, kb = item / nblk, nb = item % nblk, k0 = 64 * kb, n0 = 64 * nb;
    const int r4 = lane >> 4, c4 = (lane & 15) * 4;
    f32x4 v[16];
#pragma unroll
    for (int i = 0; i < 16; ++i) v[i] = *(const GAS f32x4*)(W + (size_t)(k0 + 16 * r4 + i) * N + n0 + c4);
    if (gain) {
#pragma unroll
        for (int i = 0; i < 16; ++i) v[i] = v[i] * gain[k0 + 16 * r4 + i]; }
    const int nd0 = maprow(mode, n0);
#pragma unroll
    for (int e = 0; e < 4; ++e)
#pragma unroll
        for (int h2 = 0; h2 < 2; ++h2) { v4u o; o.x = pk2(v[8 * h2][e], v[8 * h2 + 1][e]); o.y = pk2(v[8 * h2 + 2][e], v[8 * h2 + 3][e]); o.z = pk2(v[8 * h2 + 4][e], v[8 * h2 + 5][e]); o.w = pk2(v[8 * h2 + 6][e], v[8 * h2 + 7][e]);
            *(GAS v4u*)(WT + (size_t)(nd0 + c4 + e) * K + k0 + 16 * r4 + 8 * h2) = o; }
}

struct Args { const float* in[15]; float* out; unsigned char* ws; int ph_lo, ph_hi, coop, pad; };

__global__ void __launch_bounds__(NWAVES * 64, 2) fwd_kernel(Args args_) {
    extern __shared__ __attribute__((aligned(16))) unsigned char lds[];
    {   LAS unsigned char* L0 = (LAS unsigned char*)lds;
        for (int u = threadIdx.x; u < (LDS_BYTES - LDSCTL_OFF) / 4; u += NWAVES * 64) ((LAS unsigned*)(L0 + LDSCTL_OFF))[u] = 0u;
        __syncthreads();
        if (args_.ph_hi - args_.ph_lo > 1) (void)xcd_barrier_post((unsigned*)(args_.ws + WS_CTL) + CW_BAR, (volatile LAS unsigned*)(L0 + MISC_OFF) + 8); }
    const int lo = args_.ph_lo, hi = args_.ph_hi;
    for (int ph = lo; ph < hi; ++ph) {
#if defined(PROBE_S0)
        const int reps = (ph != N_PHASES - 1 && (ph % 9 == PROBE_S0 || ph % 9 == PROBE_S1)) ? 2 : 1;
#else
        const int reps = 1;
#endif
        for (int rep = 0; rep < reps; ++rep) {
        const __attribute__((address_space(4))) Args* ap = (const __attribute__((address_space(4))) Args*)__builtin_amdgcn_kernarg_segment_ptr();
        asm volatile("" : "+s"(ap));
        const __attribute__((address_space(4))) Args& args = *ap;
        LAS unsigned char* L = (LAS unsigned char*)lds;
        const int tid = ltid(), lane = tid & 63, wave = __builtin_amdgcn_readfirstlane(tid >> 6);
        const int G = gridDim.x, bid = blockIdx.x;
        const int vcu = (G % 8 == 0) ? (bid % 8) * (G / 8) + bid / 8 : bid;
        unsigned char* ws = args.ws;
        const int gw = vcu * NWAVES + wave, NGW = G * NWAVES;
        const int l = ph / 9, s = ph % 9;
        if (ph == N_PHASES - 1) {
            const float* gfin = args.in[14]; float* const out = args.out;
            for (int m = gw; m < M; m += NGW) { GAS f32x4* xr = (GAS f32x4*)(out + (size_t)m * D) + lane; f32x4 v[4]; float sq = 0.f;
#pragma unroll
                for (int j = 0; j < 4; ++j) { v[j] = xr[64 * j]; sq += (v[j].x * v[j].x + v[j].y * v[j].y) + (v[j].z * v[j].z + v[j].w * v[j].w); }
                const float rs = 1.0f / sqrtf(wave_sum(sq) * (1.0f / D) + 1e-6f);
#pragma unroll
                for (int j = 0; j < 4; ++j) { const f32x4 gg = *((const f32x4*)gfin + 64 * j + lane); xr[64 * j] = v[j] * rs * gg; } }
        } else if (s == 0) {
            const float* w13a = args.in[2] + (size_t)l * D * 2 * FF; const float* w2a = args.in[3] + (size_t)l * FF * D; const float* win = args.in[5] + (size_t)l * D * NIN;
            const float* wc = args.in[8] + (size_t)l * 512 * D; const float* wa = args.in[9] + (size_t)l * 512 * D; const float* wo = args.in[10] + (size_t)l * D * D;
            const float* w13b = args.in[12] + (size_t)l * D * 2 * FF; const float* w2b = args.in[13] + (size_t)l * FF * D;
            const float* g1 = args.in[1] + l * D; const float* gm = args.in[4] + l * D; const float* g2 = args.in[11] + l * D;
            constexpr int I13 = (D / 64) * (2 * FF / 64), I2 = (FF / 64) * (D / 64), IIN = (D / 64) * (NIN / 64), ICO = (512 / 64) * (D / 64), IO = (D / 64) * (D / 64);
            constexpr int NITEMS = 2 * I13 + 2 * I2 + IIN + 2 * ICO + IO;
            for (int it = gw; it < NITEMS; it += NGW) {
                int r = it;
                if (r < I13) { transpose_item(w13a, D, 2 * FF, (bf16*)(ws + WS_W13A), g1, 1, r, lane); continue; } r -= I13;
                if (r < I13) { transpose_item(w13b, D, 2 * FF, (bf16*)(ws + WS_W13B), g2, 1, r, lane); continue; } r -= I13;
                if (r < IIN) { transpose_item(win, D, NIN, (bf16*)(ws + WS_WIN), gm, 2, r, lane); continue; } r -= IIN;
                if (r < I2) { transpose_item(w2a, FF, D, (bf16*)(ws + WS_W2A), nullptr, 0, r, lane); continue; } r -= I2;
                if (r < I2) { transpose_item(w2b, FF, D, (bf16*)(ws + WS_W2B), nullptr, 0, r, lane); continue; } r -= I2;
                if (r < IO) { transpose_item(wo, D, D, (bf16*)(ws + WS_WO), nullptr, 0, r, lane); continue; } r -= IO;
                if (r < ICO) { transpose_item(wc, 512, D, (bf16*)(ws + WS_WC), nullptr, 0, r, lane); continue; } r -= ICO;
                transpose_item(wa, 512, D, (bf16*)(ws + WS_WA), nullptr, 0, r, lane);
            }
            if (l == 0) {
                const float* x = args.in[0]; bf16* const XB = (bf16*)(ws + WS_XB); float* const ssq = (float*)(ws + WS_SSQ);
                for (int m = 2 * gw; m < M; m += 2 * NGW) { const GAS f32x4* xr = (const GAS f32x4*)(x + (size_t)m * D) + lane; f32x4 v[8];
#pragma unroll
                    for (int j = 0; j < 8; ++j) v[j] = xr[64 * j];
#pragma unroll
                    for (int h2 = 0; h2 < 2; ++h2) { float sq = 0.f;
#pragma unroll
                        for (int j = 0; j < 4; ++j) { const f32x4 w = v[4 * h2 + j]; sq += (w.x * w.x + w.y * w.y) + (w.z * w.z + w.w * w.w); }
                        sq = wave_sum(sq);
                        GAS unsigned long long* o8 = (GAS unsigned long long*)(XB + (size_t)(m + h2) * D) + lane;
#pragma unroll
                        for (int j = 0; j < 4; ++j) { const f32x4 w = v[4 * h2 + j]; o8[64 * j] = (unsigned long long)pk2(w.x, w.y) | ((unsigned long long)pk2(w.z, w.w) << 32); }
                        if (lane < 16) ssq[(size_t)(m + h2) * 16 + lane] = lane == 0 ? sq : 0.f; } }
            }
        } else if (s == 4) {
            const float* cw = args.in[7] + (size_t)l * 3 * 512;
            bf16* const CB = (bf16*)(ws + WS_CB); bf16* const U = (bf16*)(ws + WS_U); bf16* const Qb = (bf16*)(ws + WS_Q); bf16* const Kb = (bf16*)(ws + WS_K); bf16* const Vb = (bf16*)(ws + WS_V); bf16* const YA = (bf16*)(ws + WS_YA);
            if (rep == 0) for (int i = bid * (NWAVES * 64) + tid; i < M * 64; i += G * NWAVES * 64) { const int row = i >> 6, c0 = (i & 63) * 8, t = row & (SEQ - 1);
                const pg8::u32x4e zero4 = {0u, 0u, 0u, 0u};
                const pg8::u32x4e cbv = *(const pg8::u32x4e*)(CB + (size_t)row * 512 + c0), u2 = *(const pg8::u32x4e*)(U + (size_t)row * 512 + c0);
                const pg8::u32x4e u1 = t >= 1 ? *(const pg8::u32x4e*)(U + (size_t)(row - 1) * 512 + c0) : zero4, u0 = t >= 2 ? *(const pg8::u32x4e*)(U + (size_t)(row - 2) * 512 + c0) : zero4;
                f32x4 cb0, cb1, a0, a1, b0, b1, c0v, c1v; pg8::unpack8(cbv, cb0, cb1); pg8::unpack8(u0, a0, a1); pg8::unpack8(u1, b0, b1); pg8::unpack8(u2, c0v, c1v);
                const f32x4 w00 = *(const f32x4*)(cw + c0), w01 = *(const f32x4*)(cw + c0 + 4), w10 = *(const f32x4*)(cw + 512 + c0), w11 = *(const f32x4*)(cw + 512 + c0 + 4), w20 = *(const f32x4*)(cw + 1024 + c0), w21 = *(const f32x4*)(cw + 1024 + c0 + 4);
                const f32x4 y0 = cb0 * (w00 * a0 + w10 * b0 + w20 * c0v), y1 = cb1 * (w01 * a1 + w11 * b1 + w21 * c1v);
                *(pg8::u32x4e*)(CB + (size_t)row * 512 + c0) = pg8::pack8(y0, y1); }
            __syncthreads();
            for (int p = vcu; p < 256; p += G) { const int bh = p >> 2, sI = p & 3;
                sba::attn_unit(bh >> 3, bh & 7, 7 - sI, Qb, Kb, Vb, YA, L);
                sba::attn_unit(bh >> 3, bh & 7, sI, Qb, Kb, Vb, YA, L); }
        } else {
            const int ncall = (s == 5) ? 2 : 1;
            for (int c = 0; c < ncall; ++c) {
                pg8::Gemm g{}; pg8::EpiAll E{};
                E.ws = ws; E.outf = args.out; E.base = args.out; E.alpha = 0.5f; E.bgate = args.in[6] + (size_t)l * 2048;
                g.M = M;
                if (s == 1)      { g.A = (const bf16*)(ws + WS_XB);  g.Bt = (const bf16*)(ws + WS_W13A); g.N = 2 * FF; g.K = D;  E.mode = pg8::EP_SWIGLU; }
                else if (s == 2) { g.A = (const bf16*)(ws + WS_ACT); g.Bt = (const bf16*)(ws + WS_W2A);  g.N = D;      g.K = FF; E.mode = pg8::EP_RESID; if (l == 0) E.base = args.in[0]; }
                else if (s == 3) { g.A = (const bf16*)(ws + WS_XB);  g.Bt = (const bf16*)(ws + WS_WIN);  g.N = NIN;    g.K = D;  E.mode = pg8::EP_WIN; }
                else if (s == 5) { if (c == 0) { g.A = (const bf16*)(ws + WS_YA); g.Bt = (const bf16*)(ws + WS_WA); E.mode = pg8::EP_MERGE1; } else { g.A = (const bf16*)(ws + WS_CB); g.Bt = (const bf16*)(ws + WS_WC); E.mode = pg8::EP_MERGE2; } g.N = D; g.K = 512; }
                else if (s == 6) { g.A = (const bf16*)(ws + WS_MG);  g.Bt = (const bf16*)(ws + WS_WO);   g.N = D;      g.K = D;  E.mode = pg8::EP_RESID; E.alpha = 1.0f; }
                else if (s == 7) { g.A = (const bf16*)(ws + WS_XB);  g.Bt = (const bf16*)(ws + WS_W13B); g.N = 2 * FF; g.K = D;  E.mode = pg8::EP_SWIGLU; }
                else             { g.A = (const bf16*)(ws + WS_ACT); g.Bt = (const bf16*)(ws + WS_W2B);  g.N = D;      g.K = FF; E.mode = pg8::EP_RESID; }
                pg8::StaticOrder S; S.init(M, g.N, G, bid);
                pg8::gemm_phase<pg8::EpiAll, pg8::StaticOrder, true, true>(L, g, S, E);
            }
        }
        }
        if (ph + 1 < hi) {
            if (args_.coop == 2) { __threadfence(); cg::this_grid().sync(); }
            else { XcdBarrier bar; bar.bar = (unsigned*)(args_.ws + WS_CTL) + CW_BAR; bar.x = xb_xcc_id(); bar.st = (volatile LAS unsigned*)((LAS unsigned char*)lds + MISC_OFF) + 8; xcd_barrier(bar); }
        }
    }
}

extern "C" void kernel_launch(void* const* d_in, const int* in_sizes, int n_in, void* d_out, int out_size, void* d_ws, size_t ws_size, hipStream_t stream) {
    static int grid = 0;
    if (grid == 0) {
        if (n_in != 15 || in_sizes[0] != M * D || out_size != M * D || ws_size < WS_END) { fprintf(stderr, "kernel_launch: unexpected shapes (n_in %d, in0 %d, out %d, ws %zu); nothing launched\n", n_in, n_in > 0 ? in_sizes[0] : -1, out_size, ws_size); grid = -1; return; }
        int dev = 0, cus = 0, per_cu = 0;
        if (hipGetDevice(&dev) != hipSuccess || hipDeviceGetAttribute(&cus, hipDeviceAttributeMultiprocessorCount, dev) != hipSuccess) { grid = -1; return; }
        if (hipFuncSetAttribute((const void*)fwd_kernel, hipFuncAttributeMaxDynamicSharedMemorySize, LDS_BYTES) != hipSuccess) { fprintf(stderr, "kernel_launch: hipFuncSetAttribute failed\n"); grid = -1; return; }
        if (hipOccupancyMaxActiveBlocksPerMultiprocessor(&per_cu, (const void*)fwd_kernel, NWAVES * 64, LDS_BYTES) != hipSuccess || per_cu < 1) { fprintf(stderr, "kernel_launch: occupancy query says %d blocks per CU; nothing launched\n", per_cu); (void)hipGetLastError(); grid = -1; return; }
        grid = cus < 256 ? cus : 256;
    }
    if (grid < 0) return;
    if (hipMemsetAsync((char*)d_ws + WS_CTL, 0, CTL_ZERO_BYTES, stream) != hipSuccess) { fprintf(stderr, "kernel_launch: hipMemsetAsync failed\n"); return; }
    Args a{};
    for (int i = 0; i < 15; ++i) a.in[i] = (const float*)d_in[i];
    a.out = (float*)d_out; a.ws = (unsigned char*)d_ws;
#if MK_PER_PHASE
    for (int ph = 0; ph < N_PHASES; ++ph) { a.ph_lo = ph; a.ph_hi = ph + 1; a.coop = 0;
        hipLaunchKernelGGL(fwd_kernel, dim3(grid), dim3(NWAVES * 64), LDS_BYTES, stream, a); }
#else
    a.ph_lo = 0; a.ph_hi = N_PHASES; a.coop = 1;
    void* kargs[] = {&a};
    const hipError_t e = hipLaunchCooperativeKernel((const void*)fwd_kernel, dim3(grid), dim3(NWAVES * 64), kargs, LDS_BYTES, stream);
    if (e != hipSuccess) fprintf(stderr, "kernel_launch: cooperative launch failed: %s (grid %d)\n", hipGetErrorString(e), grid);
#endif
}
```

```cpp
#include <hip/hip_runtime.h>
#include <hip/hip_cooperative_groups.h>
#include <cstdio>
#include <cstdint>
namespace cg = cooperative_groups;
__device__ __forceinline__ int ltid() { int t = threadIdx.x; asm volatile("" : "+v"(t)); return t; }
namespace pg8 {
#define PG8_LAS __attribute__((address_space(3)))
typedef unsigned short bf16_t;
typedef short bf16x8 __attribute__((ext_vector_type(8)));
typedef float f32x4 __attribute__((ext_vector_type(4)));
typedef unsigned u32x4 __attribute__((ext_vector_type(4)));
constexpr int BM = 256, BK = 64, HALF = 128, HTB = HALF * BK * 2  , STAGE_BYTES = 8 * HTB, NXCD = 8, WGM = 8;

__host__ __device__ __forceinline__ int lds_byte(int r, int c) { const int st = (r >> 4) * 2 + (c >> 5), rr = r & 15, cc = c & 31, ob = rr * 64 + cc * 2; return st * 1024 + (ob ^ (((ob >> 9) & 1) << 5)); }
__host__ __device__ __forceinline__ void stage_rc(int b, int& R, int& C) { const int st = b / 1024, sb = b % 1024, swz = sb ^ (((sb >> 9) & 1) << 5); R = (st >> 1) * 16 + swz / 64; C = (st & 1) * 32 + (swz % 64) / 2; }
__host__ __device__ __forceinline__ int perm32(int rho) { const int n = rho >> 4, i = rho & 15; return 8 * (i >> 2) + 4 * n + (i & 3); }

struct Unit { int pm, pn; };
struct Gemm { const bf16_t* A; const bf16_t* Bt; int M, N, K; };

struct StaticOrder {
    int nM, nN, nwg, G, c;
    __host__ __device__ void init(int M, int N, int G_, int c_) { nM = M / BM; nN = N / BM; nwg = nM * nN; G = G_; c = c_; }
    __host__ __device__ bool next(int i, Unit& u) const {
        const long L = (long)i * G + c; if (L >= nwg) return false;
        int wgid = (int)L; { const int q = nwg / NXCD, r = nwg % NXCD, xcd = wgid % NXCD, off = wgid / NXCD; wgid = (xcd < r ? xcd * (q + 1) : r * (q + 1) + (xcd - r) * q) + off; }
        const int nig = WGM * nN, gid = wgid / nig, fm = gid * WGM, gsz = (nM - fm) < WGM ? (nM - fm) : WGM;
        u.pm = fm + ((wgid % nig) % gsz); u.pn = (wgid % nig) / gsz; return true;
    }
    __device__ __forceinline__ void a_ready(const Unit&) const {}
    __device__ __forceinline__ void done(const Unit&) const {}
};

__device__ __forceinline__ unsigned cvt_pk_bf16(float lo, float hi) { unsigned r; asm volatile("v_cvt_pk_bf16_f32 %0, %1, %2" : "=v"(r) : "v"(lo), "v"(hi)); return r; }
typedef float f32x2 __attribute__((ext_vector_type(2)));

typedef unsigned u32x4e __attribute__((ext_vector_type(4)));
constexpr float LOG2E = 1.4426950408889634f;
constexpr float QSCALE = 0.125f * LOG2E;
__device__ __forceinline__ float rowscale(const float* ssq, int row) {
    const f32x4* p = (const f32x4*)(ssq + (size_t)row * 16);
    const f32x4 s = (p[0] + p[1]) + (p[2] + p[3]);
    return __builtin_amdgcn_rsqf(((s[0] + s[1]) + (s[2] + s[3])) * (1.0f / 1024.0f) + 1e-6f);
}
__device__ __forceinline__ float sigmoid_f(float x) { return __builtin_amdgcn_rcpf(1.0f + __builtin_amdgcn_exp2f(-x * LOG2E)); }
__device__ __forceinline__ u32x4e pack8(const f32x4 a, const f32x4 b) { u32x4e w; w.x = cvt_pk_bf16(a[0], a[1]); w.y = cvt_pk_bf16(a[2], a[3]); w.z = cvt_pk_bf16(b[0], b[1]); w.w = cvt_pk_bf16(b[2], b[3]); return w; }
__device__ __forceinline__ void unpack8(const u32x4e w, f32x4& a, f32x4& b) {
    a[0] = __uint_as_float(w.x << 16); a[1] = __uint_as_float(w.x & 0xffff0000u); a[2] = __uint_as_float(w.y << 16); a[3] = __uint_as_float(w.y & 0xffff0000u);
    b[0] = __uint_as_float(w.z << 16); b[1] = __uint_as_float(w.z & 0xffff0000u); b[2] = __uint_as_float(w.w << 16); b[3] = __uint_as_float(w.w & 0xffff0000u);
}
constexpr size_t EMiB = 1u << 20;
constexpr size_t EWS_SSQ = 1 * EMiB, EWS_XB = 49 * EMiB, EWS_ACT = 81 * EMiB, EWS_CB = 81 * EMiB, EWS_U = 97 * EMiB, EWS_Q = 113 * EMiB, EWS_K = 129 * EMiB, EWS_V = 145 * EMiB, EWS_G = 161 * EMiB, EWS_MG = 129 * EMiB;
enum { EP_SWIGLU = 0, EP_RESID = 1, EP_WIN = 2, EP_MERGE1 = 3, EP_MERGE2 = 4 };
struct EpiAll {
    static constexpr bool PERM = true, AFTER_DRAIN = false;
    int mode; float alpha;
    unsigned char* ws;
    float* outf;
    const float* base;
    const float* bgate;
    __device__ __forceinline__ void operator()(const f32x4 (&acc)[2][2][4][2], const Unit& u, int wr, int wc, int fr, int fq) const {
        const int row0 = u.pm * BM + wr * 64 + fr, lc = wc * 32 + 8 * fq, pn = u.pn;
        const float* ssq = (const float*)(ws + EWS_SSQ); float* ssq_out = (float*)(ws + EWS_SSQ);
        bf16_t* act = (bf16_t*)(ws + EWS_ACT); bf16_t* xb = (bf16_t*)(ws + EWS_XB);
        bf16_t* cb = (bf16_t*)(ws + EWS_CB); bf16_t* uu = (bf16_t*)(ws + EWS_U); bf16_t* q = (bf16_t*)(ws + EWS_Q); bf16_t* k = (bf16_t*)(ws + EWS_K); bf16_t* v = (bf16_t*)(ws + EWS_V);
        bf16_t* g = (bf16_t*)(ws + EWS_G); bf16_t* mg = (bf16_t*)(ws + EWS_MG);
        if (mode == EP_SWIGLU) {
#pragma unroll
            for (int ai = 0; ai < 2; ++ai)
#pragma unroll
                for (int m = 0; m < 4; ++m) { const int row = row0 + ai * HALF + m * 16; const float rs = rowscale(ssq, row);
                    f32x4 o[2];
#pragma unroll
                    for (int n = 0; n < 2; ++n) { const f32x4 a = acc[ai][0][m][n] * rs, b = acc[ai][1][m][n] * rs;
#pragma unroll
                        for (int e = 0; e < 4; ++e) o[n][e] = a[e] * sigmoid_f(a[e]) * b[e]; }
                    *(u32x4e*)(act + (size_t)row * 2816 + pn * 128 + lc) = pack8(o[0], o[1]); }
        } else if (mode == EP_RESID) {
#pragma unroll
            for (int ai = 0; ai < 2; ++ai)
#pragma unroll
                for (int m = 0; m < 4; ++m) { const int row = row0 + ai * HALF + m * 16; float s = 0.f;
#pragma unroll
                    for (int bj = 0; bj < 2; ++bj) { const size_t off = (size_t)row * 1024 + pn * BM + bj * HALF + lc;
                        f32x4 x0, x1;
                        if (base) { x0 = *(const f32x4*)(base + off); x1 = *(const f32x4*)(base + off + 4); } else unpack8(*(const u32x4e*)(xb + off), x0, x1);
                        const f32x4 y0 = x0 + acc[ai][bj][m][0] * alpha, y1 = x1 + acc[ai][bj][m][1] * alpha;
                        if (outf) { *(f32x4*)(outf + off) = y0; *(f32x4*)(outf + off + 4) = y1; } else *(u32x4e*)(xb + off) = pack8(y0, y1);
                        s += (y0[0] * y0[0] + y0[1] * y0[1]) + (y0[2] * y0[2] + y0[3] * y0[3]) + (y1[0] * y1[0] + y1[1] * y1[1]) + (y1[2] * y1[2] + y1[3] * y1[3]); }
                    s += __shfl_xor(s, 16); s += __shfl_xor(s, 32);
                    if (fq == 0) ssq_out[(size_t)row * 16 + pn * 4 + wc] = s; }
        } else if (mode == EP_WIN) {
#pragma unroll
            for (int ai = 0; ai < 2; ++ai)
#pragma unroll
                for (int m = 0; m < 4; ++m) { const int row = row0 + ai * HALF + m * 16; const float rs = rowscale(ssq, row);
                    if (pn >= 2 && pn < 6) {
                        const float rs2 = rs * rs;
                        const f32x4 o0 = acc[ai][0][m][0] * acc[ai][1][m][0] * rs2, o1 = acc[ai][0][m][1] * acc[ai][1][m][1] * rs2;
                        *(u32x4e*)(uu + (size_t)row * 512 + (pn - 2) * 128 + lc) = pack8(o0, o1);
                    } else {
#pragma unroll
                        for (int bj = 0; bj < 2; ++bj) { const int col = bj * HALF + lc;
                            if (pn < 2) { *(u32x4e*)(cb + (size_t)row * 512 + pn * BM + col) = pack8(acc[ai][bj][m][0] * rs, acc[ai][bj][m][1] * rs); }
                            else if (pn < 12) { const int t = (pn - 6) >> 1; bf16_t* dst = t == 0 ? q : (t == 1 ? k : v); const float sc = t == 0 ? rs * QSCALE : rs;
                                *(u32x4e*)(dst + (size_t)row * 512 + ((pn - 6) & 1) * BM + col) = pack8(acc[ai][bj][m][0] * sc, acc[ai][bj][m][1] * sc); }
                            else { const int gc = (pn - 12) * BM + col; const f32x4 b0 = *(const f32x4*)(bgate + gc), b1 = *(const f32x4*)(bgate + gc + 4);
                                const f32x4 z0 = acc[ai][bj][m][0] * rs + b0, z1 = acc[ai][bj][m][1] * rs + b1; f32x4 o0, o1;
#pragma unroll
                                for (int e = 0; e < 4; ++e) { o0[e] = sigmoid_f(z0[e]); o1[e] = sigmoid_f(z1[e]); }
                                *(u32x4e*)(g + (size_t)row * 2048 + gc) = pack8(o0, o1); } }
                    } }
        } else {
#pragma unroll
            for (int ai = 0; ai < 2; ++ai)
#pragma unroll
                for (int m = 0; m < 4; ++m) { const int row = row0 + ai * HALF + m * 16;
#pragma unroll
                    for (int bj = 0; bj < 2; ++bj) { const int col = pn * BM + bj * HALF + lc; bf16_t* ga = g + (size_t)row * 2048 + 1024 + col;
                        if (mode == EP_MERGE1) { f32x4 g0, g1; unpack8(*(const u32x4e*)ga, g0, g1); *(u32x4e*)ga = pack8(g0 * acc[ai][bj][m][0], g1 * acc[ai][bj][m][1]); }
                        else { f32x4 g0, g1, m0, m1; unpack8(*(const u32x4e*)(g + (size_t)row * 2048 + col), g0, g1); unpack8(*(const u32x4e*)ga, m0, m1);
                            *(u32x4e*)(mg + (size_t)row * 1024 + col) = pack8(m0 + g0 * acc[ai][bj][m][0], m1 + g1 * acc[ai][bj][m][1]); } } }
        }
    }
};
template <class Epi, class Sched, bool ALIGN_EPI = false, bool SP2 = false>
__device__ __forceinline__ void gemm_phase(PG8_LAS unsigned char* lds, const Gemm g, const Sched& S, const Epi& E) {
    const int tid = ltid(), wid = __builtin_amdgcn_readfirstlane(tid >> 6), lane = tid & 63, wr = wid >> 2, wc = wid & 3, fr = lane & 15, fq = lane >> 4;
    const int K = g.K, nt = K / BK;
    unsigned voffA[2], voffB[2];
#pragma unroll
    for (int i = 0; i < 2; ++i) { int R, C; stage_rc(tid * 16 + i * 8192, R, C); const int Rb = Epi::PERM ? ((R & ~31) + perm32(R & 31)) : R;
        voffA[i] = (unsigned)(R * K + C) * 2u; voffB[i] = (unsigned)(Rb * K + C) * 2u; }
    const size_t kstep = (size_t)(BK * 2);
    const size_t hstep = (size_t)HALF * K * 2;
    const size_t tstep = 2 * hstep;
    const unsigned ldsw = (unsigned)wid * 1024u;
    const int aoff = lds_byte(wr * 64 + fr, fq * 8), boff = lds_byte(wc * 32 + fr, fq * 8);
#define PG8_SA(b, h) (((b) * 2 + (h)) * HTB)
#define PG8_SB(b, h) ((4 + (b) * 2 + (h)) * HTB)
#define PG8_STAGE(bufoff, gbase, voff) do { _Pragma("unroll") for (int _i = 0; _i < 2; ++_i) \
        __builtin_amdgcn_global_load_lds((const unsigned*)((const char*)(gbase) + (voff)[_i]), (PG8_LAS unsigned*)(lds + (bufoff) + ldsw + _i * 8192), 16, 0, 0); } while (0)
#define PG8_LDA(dst, b, h) do { _Pragma("unroll") for (int m = 0; m < 4; ++m) _Pragma("unroll") for (int k = 0; k < 2; ++k) dst[m][k] = *(const PG8_LAS bf16x8*)(lds + PG8_SA(b, h) + aoff + m * 2048 + k * 1024); } while (0)
#define PG8_LDB(dst, b, h) do { _Pragma("unroll") for (int n = 0; n < 2; ++n) _Pragma("unroll") for (int k = 0; k < 2; ++k) dst[n][k] = *(const PG8_LAS bf16x8*)(lds + PG8_SB(b, h) + boff + n * 2048 + k * 1024); } while (0)
#define PG8_MMA(ai, bj, At, Bt) do { __builtin_amdgcn_s_setprio(1); _Pragma("unroll") for (int m = 0; m < 4; ++m) _Pragma("unroll") for (int n = 0; n < 2; ++n) _Pragma("unroll") for (int k = 0; k < 2; ++k) \
        acc[ai][bj][m][n] = __builtin_amdgcn_mfma_f32_16x16x32_bf16(Bt[n][k], At[m][k], acc[ai][bj][m][n], 0, 0, 0); __builtin_amdgcn_s_setprio(0); } while (0)
#define PG8_WAIT_V(n) asm volatile("s_waitcnt vmcnt(" #n ")" ::: "memory")
#define PG8_WAIT_L(n) asm volatile("s_waitcnt lgkmcnt(" #n ")" ::: "memory")
#define PG8_BAR __builtin_amdgcn_s_barrier()
#define PG8_SCHED __builtin_amdgcn_sched_barrier(0)
    Unit cur, nxt; int ui = 0;
    if (!S.next(0, cur)) return;
    f32x4 acc[2][2][4][2];
#pragma unroll
    for (int a = 0; a < 2; ++a)
#pragma unroll
        for (int b = 0; b < 2; ++b)
#pragma unroll
            for (int m = 0; m < 4; ++m)
#pragma unroll
                for (int n = 0; n < 2; ++n) acc[a][b][m][n] = (f32x4){0.f, 0.f, 0.f, 0.f};
    bf16x8 At[4][2], B0[2][2], B1[2][2];
    const char* cA = (const char*)g.A + (size_t)cur.pm * tstep; const char* cB = (const char*)g.Bt + (size_t)cur.pn * tstep;
    S.a_ready(cur);
    if constexpr (SP2) {
        PG8_STAGE(PG8_SB(0, 0), cB, voffB); PG8_STAGE(PG8_SB(0, 1), cB + hstep, voffB); PG8_STAGE(PG8_SA(0, 0), cA, voffA); PG8_STAGE(PG8_SA(0, 1), cA + hstep, voffA);
        if (wr == 1) PG8_BAR;
        PG8_WAIT_V(2); PG8_BAR;
        PG8_STAGE(PG8_SB(1, 0), cB + kstep, voffB); PG8_STAGE(PG8_SA(1, 0), cA + kstep, voffA); PG8_STAGE(PG8_SB(1, 1), cB + hstep + kstep, voffB);
        PG8_WAIT_V(6); PG8_BAR;
    } else {
        PG8_STAGE(PG8_SB(0, 0), cB, voffB); PG8_STAGE(PG8_SA(0, 0), cA, voffA); PG8_STAGE(PG8_SB(0, 1), cB + hstep, voffB); PG8_STAGE(PG8_SA(0, 1), cA + hstep, voffA);
        if (wr == 1) PG8_BAR;
        PG8_WAIT_V(4); PG8_BAR;
        PG8_STAGE(PG8_SB(1, 0), cB + kstep, voffB); PG8_STAGE(PG8_SA(1, 0), cA + kstep, voffA); PG8_STAGE(PG8_SB(1, 1), cB + hstep + kstep, voffB);
        PG8_WAIT_V(6); PG8_BAR;
    }
    for (;;) {
        const bool has_next = S.next(ui + 1, nxt);
        const char* nA = has_next ? (const char*)g.A + (size_t)nxt.pm * tstep : cA; const char* nB = has_next ? (const char*)g.Bt + (size_t)nxt.pn * tstep : cB;
        for (int t = 0; t < nt; t += 2) {
            const bool last = (t == nt - 2);
            const char* a1 = cA + (size_t)(t + 1) * kstep;
            const char* a2 = last ? nA : cA + (size_t)(t + 2) * kstep; const char* b2 = last ? nB : cB + (size_t)(t + 2) * kstep;
            const char* a3 = a2 + kstep; const char* b3 = b2 + kstep;
            if (last && has_next) S.a_ready(nxt);
            if constexpr (SP2) {
            PG8_LDB(B0, 0, 0); PG8_LDB(B1, 0, 1); PG8_SCHED; PG8_LDA(At, 0, 0); PG8_STAGE(PG8_SA(1, 1), a1 + hstep, voffA);
            PG8_WAIT_V(8); PG8_WAIT_L(0); PG8_BAR; PG8_MMA(0, 0, At, B0); PG8_MMA(0, 1, At, B1); PG8_BAR; PG8_SCHED;
            PG8_LDA(At, 0, 1); PG8_STAGE(PG8_SB(0, 0), b2, voffB); PG8_STAGE(PG8_SB(0, 1), b2 + hstep, voffB); PG8_STAGE(PG8_SA(0, 0), a2, voffA);
            PG8_WAIT_V(8); PG8_WAIT_L(0); PG8_BAR; PG8_MMA(1, 0, At, B0); PG8_MMA(1, 1, At, B1); PG8_BAR; PG8_SCHED;
            PG8_LDB(B0, 1, 0); PG8_LDB(B1, 1, 1); PG8_SCHED; PG8_LDA(At, 1, 0); PG8_STAGE(PG8_SA(0, 1), a2 + hstep, voffA);
            PG8_WAIT_V(8); PG8_WAIT_L(0); PG8_BAR; PG8_MMA(0, 0, At, B0); PG8_MMA(0, 1, At, B1); PG8_BAR; PG8_SCHED;
            PG8_LDA(At, 1, 1); PG8_STAGE(PG8_SB(1, 0), b3, voffB); PG8_STAGE(PG8_SB(1, 1), b3 + hstep, voffB); PG8_STAGE(PG8_SA(1, 0), a3, voffA);
            PG8_WAIT_V(8); PG8_WAIT_L(0); PG8_BAR; PG8_MMA(1, 0, At, B0); PG8_MMA(1, 1, At, B1); PG8_BAR; PG8_SCHED;
            } else {
            PG8_LDB(B0, 0, 0); PG8_SCHED; PG8_LDA(At, 0, 0); PG8_STAGE(PG8_SA(1, 1), a1 + hstep, voffA);
            PG8_WAIT_L(8); PG8_BAR; PG8_WAIT_L(0); PG8_MMA(0, 0, At, B0); PG8_BAR; PG8_SCHED;
            PG8_LDB(B1, 0, 1); PG8_STAGE(PG8_SB(0, 0), b2, voffB);
            PG8_BAR; PG8_WAIT_L(0); PG8_MMA(0, 1, At, B1); PG8_BAR;
            PG8_LDA(At, 0, 1); PG8_STAGE(PG8_SA(0, 0), a2, voffA);
            PG8_BAR; PG8_WAIT_L(0); PG8_MMA(1, 0, At, B0); PG8_BAR; PG8_SCHED;
            PG8_STAGE(PG8_SB(0, 1), b2 + hstep, voffB);
            PG8_WAIT_V(6); PG8_BAR; PG8_MMA(1, 1, At, B1); PG8_BAR;
            PG8_LDB(B0, 1, 0); PG8_SCHED; PG8_LDA(At, 1, 0); PG8_STAGE(PG8_SA(0, 1), a2 + hstep, voffA);
            PG8_WAIT_L(8); PG8_BAR; PG8_WAIT_L(0); PG8_MMA(0, 0, At, B0); PG8_BAR; PG8_SCHED;
            PG8_LDB(B1, 1, 1); PG8_STAGE(PG8_SB(1, 0), b3, voffB);
            PG8_BAR; PG8_WAIT_L(0); PG8_MMA(0, 1, At, B1); PG8_BAR;
            PG8_LDA(At, 1, 1); PG8_STAGE(PG8_SA(1, 0), a3, voffA);
            PG8_BAR; PG8_WAIT_L(0); PG8_MMA(1, 0, At, B0); PG8_BAR; PG8_SCHED;
            PG8_STAGE(PG8_SB(1, 1), b3 + hstep, voffB);
            PG8_WAIT_V(6); PG8_BAR; PG8_MMA(1, 1, At, B1); PG8_BAR;
            }
        }
        if constexpr (ALIGN_EPI) { if (wr == 0) PG8_BAR; }
        if constexpr (!Epi::AFTER_DRAIN) { E(acc, cur, wr, wc, fr, fq); S.done(cur); }
        if (!has_next) break;
#pragma unroll
        for (int a = 0; a < 2; ++a)
#pragma unroll
            for (int b = 0; b < 2; ++b)
#pragma unroll
                for (int m = 0; m < 4; ++m)
#pragma unroll
                    for (int n = 0; n < 2; ++n) acc[a][b][m][n] = (f32x4){0.f, 0.f, 0.f, 0.f};
        cur = nxt; cA = nA; cB = nB; ++ui;
        if constexpr (ALIGN_EPI) { if (wr == 1) PG8_BAR; }
    }
    PG8_WAIT_V(0);
    if constexpr (!ALIGN_EPI) { if (wr == 0) PG8_BAR; }
    PG8_BAR;
    if constexpr (Epi::AFTER_DRAIN) { E.fused(acc, cur, wr, wc, fr, fq, lds, wid, lane); S.done(cur); }
#undef PG8_SA
#undef PG8_SB
#undef PG8_STAGE
#undef PG8_LDA
#undef PG8_LDB
#undef PG8_MMA
#undef PG8_WAIT_V
#undef PG8_WAIT_L
#undef PG8_BAR
#undef PG8_SCHED
}
}
#define GAS __attribute__((address_space(1)))
#define LAS __attribute__((address_space(3)))
typedef unsigned short bf16;
typedef unsigned v4u __attribute__((ext_vector_type(4)));
typedef float f32x4 __attribute__((ext_vector_type(4)));
typedef short bf16x8 __attribute__((ext_vector_type(8)));
typedef GAS unsigned gu32;
typedef GAS unsigned long long gu64;
#define RLX_AGENT __ATOMIC_RELAXED, __HIP_MEMORY_SCOPE_AGENT
#define LDS_WAIT() asm volatile("s_waitcnt lgkmcnt(0)" ::: "memory")
#define VM_WAIT() asm volatile("s_waitcnt vmcnt(0)" ::: "memory")
__device__ __forceinline__ unsigned long long rt() { return __builtin_amdgcn_s_memrealtime(); }
__device__ __forceinline__ unsigned f2bf(float f) { unsigned u = __builtin_bit_cast(unsigned, f); return (u + 0x7fffu + ((u >> 16) & 1u)) >> 16; }
__device__ __forceinline__ unsigned pk2(float lo, float hi) { return f2bf(lo) | (f2bf(hi) << 16); }
#define XB_TMO      128
#define XB_XCNT(j)  (256  + 64 * (j))
#define XB_XSUB(j)  (1280 + 64 * (j))
#define XB_XGEN(j)  (2304 + 64 * (j))
#define XB_TOP      3328
#define XB_TOPGEN   3392
#define XCD_BAR_WORDS 3456
#define XB_SPIN_CAP (1u << 18)

__device__ __forceinline__ unsigned xb_ld(unsigned* p)              { return __hip_atomic_load(p, __ATOMIC_RELAXED, __HIP_MEMORY_SCOPE_AGENT); }
__device__ __forceinline__ unsigned xb_add(unsigned* p, unsigned v) { return __hip_atomic_fetch_add(p, v, __ATOMIC_RELAXED, __HIP_MEMORY_SCOPE_AGENT); }
__device__ __forceinline__ unsigned xb_xcc_id() { return (unsigned)__builtin_amdgcn_s_getreg((3 << 11) | 20) & 0xFu; }
#define XB_SPIN(cond, bar) do { unsigned _sp = 0; while (cond) { __builtin_amdgcn_s_sleep(1); \
    if ((++_sp & 255u) == 0u) { if (xb_ld(&(bar)[XB_TMO])) break; if (_sp > XB_SPIN_CAP) { atomicAdd(&(bar)[XB_TMO], 1u); break; } } } } while (0)

struct XcdBarrier {
    unsigned* bar; unsigned x;
    volatile LAS unsigned* st;
};

__device__ __forceinline__ XcdBarrier xcd_barrier_post(unsigned* bar, volatile LAS unsigned* st) {
    XcdBarrier b; b.bar = bar; b.x = xb_xcc_id(); b.st = st;
    if (threadIdx.x == 0) (void)xb_add(&bar[XB_XCNT(b.x)], 1u);
    return b;
}
__device__ __forceinline__ void xcd_barrier_complete(unsigned* bar, unsigned x, unsigned& nloc, unsigned& nx) {
    const unsigned G = gridDim.x * gridDim.y * gridDim.z;
    unsigned sum, cnt, mine, sp = 0u;
    for (;;) {
        sum = 0u; cnt = 0u; mine = 0u;
#pragma unroll
        for (unsigned j = 0; j < 16; ++j) { const unsigned c = xb_ld(&bar[XB_XCNT(j)]); sum += c; cnt += (c > 0u) ? 1u : 0u; mine = (j == x) ? c : mine; }
        if (sum == G) break;
        __builtin_amdgcn_s_sleep(1);
        if ((++sp & 255u) == 0u) { if (xb_ld(&bar[XB_TMO])) break; if (sp > XB_SPIN_CAP) { atomicAdd(&bar[XB_TMO], 1u); break; } }
    }
    nloc = mine > 0u ? mine : 1u; nx = cnt > 0u ? cnt : 1u;
}

__device__ __forceinline__ void xcd_barrier(const XcdBarrier& b) {
    asm volatile("s_waitcnt vmcnt(0)" ::: "memory");
    __syncthreads();
    if (threadIdx.x == 0) {
        unsigned* bar = b.bar;
        __builtin_amdgcn_s_waitcnt(0);
        unsigned nloc = b.st[0], nx = b.st[1];
        if (nloc == 0u) { xcd_barrier_complete(bar, b.x, nloc, nx); b.st[0] = nloc; b.st[1] = nx; }
        const unsigned old = xb_add(&bar[XB_XSUB(b.x)], 1u);
        const unsigned gen = old / nloc;
        if (old + 1u == (gen + 1u) * nloc) {
            __builtin_amdgcn_fence(__ATOMIC_RELEASE, "agent");
            asm volatile("s_waitcnt vmcnt(0)" ::: "memory");
            const unsigned og = xb_add(&bar[XB_TOP], 1u);
            const unsigned tg = og / nx;
            if (og + 1u == (tg + 1u) * nx) xb_add(&bar[XB_TOPGEN], 1u);
            else XB_SPIN(xb_ld(&bar[XB_TOPGEN]) == tg, bar);
            __builtin_amdgcn_fence(__ATOMIC_ACQUIRE, "agent");
            xb_add(&bar[XB_XGEN(b.x)], 1u);
            asm volatile("s_waitcnt vmcnt(0)" ::: "memory");
        } else {
            XB_SPIN(xb_ld(&bar[XB_XGEN(b.x)]) == gen, bar);
            __builtin_amdgcn_fence(__ATOMIC_ACQUIRE, "agent");
            asm volatile("s_waitcnt vmcnt(0)" ::: "memory");
        }
    }
    __syncthreads();
}

namespace sba {
#define LAS3 __attribute__((address_space(3)))
typedef short bf16x8 __attribute__((ext_vector_type(8)));
typedef short s16x4 __attribute__((ext_vector_type(4)));
typedef float f32x16 __attribute__((ext_vector_type(16)));
typedef unsigned u32x4 __attribute__((ext_vector_type(4)));
typedef short v4i16_t __attribute__((ext_vector_type(4)));
typedef unsigned short bf16;
constexpr int SEQ = 2048, PITCH = 512, HD = 64;
__host__ __device__ __forceinline__ constexpr int crow(int r, int hi) { return (r & 3) + 8 * (r >> 2) + 4 * hi; }
__device__ __forceinline__ unsigned cvtpk(float lo, float hi) { unsigned r; asm volatile("v_cvt_pk_bf16_f32 %0, %1, %2" : "=v"(r) : "v"(lo), "v"(hi)); return r; }
__device__ __forceinline__ s16x4 vtr(LAS3 const unsigned char* p) { return __builtin_bit_cast(s16x4, __builtin_amdgcn_ds_read_tr16_b64_v4i16((LAS3 v4i16_t*)p)); }

template <bool PARTIAL>
__device__ __forceinline__ void tile(f32x16 (&o)[2], float& carry, const bf16x8 (&qr)[4], LAS3 const unsigned char* Kslot, LAS3 const unsigned char* Vslot, int lim, int r32, int hi, int lane) {
    f32x16 p0 = {}, p1 = {};
    LAS3 const unsigned char* kb = Kslot + hi * 1024 + r32 * 16;
#pragma unroll
    for (int d0 = 0; d0 < 4; ++d0) {
        const bf16x8 b0 = *(LAS3 const bf16x8*)(kb + d0 * 2048), b1 = *(LAS3 const bf16x8*)(kb + d0 * 2048 + 512);
        p0 = __builtin_amdgcn_mfma_f32_32x32x16_bf16(b0, qr[d0], p0, 0, 0, 0);
        p1 = __builtin_amdgcn_mfma_f32_32x32x16_bf16(b1, qr[d0], p1, 0, 0, 0);
    }
    float kp[32], be[32];
#pragma unroll
    for (int i = 0; i < 32; ++i) {
        const float z = i < 16 ? p0[i] : p1[i - 16];
        const float t = __builtin_amdgcn_exp2f(-__builtin_fabsf(z));
        const float rr = __builtin_amdgcn_rcpf(1.0f + t), uu = t * rr;
        const bool pos = z >= 0.f;
        float b_ = pos ? rr : uu, k_ = pos ? uu : rr;
        if (PARTIAL) { const int c = crow(i & 15, 0) + (i >> 4) * 32; const bool valid = c < lim; b_ = valid ? b_ : 0.f; k_ = valid ? k_ : 1.f; }
        be[i] = b_; kp[i] = k_;
    }
    float E[16];
#pragma unroll
    for (int g = 0; g < 8; ++g) {
        const float gp = (kp[4 * g] * kp[4 * g + 1]) * (kp[4 * g + 2] * kp[4 * g + 3]);
        auto rr = __builtin_amdgcn_permlane32_swap(__float_as_uint(gp), __float_as_uint(gp), false, false);
        E[2 * g] = __uint_as_float(rr[0]); E[2 * g + 1] = __uint_as_float(rr[1]);
    }
    float SP[16]; SP[15] = carry;
#pragma unroll
    for (int k = 14; k >= 0; --k) SP[k] = SP[k + 1] * E[k + 1];
    carry = SP[0] * E[0];
    float a[32];
#pragma unroll
    for (int g = 0; g < 8; ++g) {
        float x = hi ? SP[2 * g + 1] : SP[2 * g];
        a[4 * g + 3] = be[4 * g + 3] * x; x *= kp[4 * g + 3];
        a[4 * g + 2] = be[4 * g + 2] * x; x *= kp[4 * g + 2];
        a[4 * g + 1] = be[4 * g + 1] * x; x *= kp[4 * g + 1];
        a[4 * g] = be[4 * g] * x;
    }
    u32x4 pw[4];
#pragma unroll
    for (int ks = 0; ks < 4; ++ks) { pw[ks].x = cvtpk(a[8 * ks], a[8 * ks + 1]); pw[ks].y = cvtpk(a[8 * ks + 2], a[8 * ks + 3]); pw[ks].z = cvtpk(a[8 * ks + 4], a[8 * ks + 5]); pw[ks].w = cvtpk(a[8 * ks + 6], a[8 * ks + 7]); }
    LAS3 const unsigned char* vb = Vslot + ((lane >> 4) & 1) * 32 + (lane & 3) * 8 + (4 * hi + ((lane & 15) >> 2)) * 64;
#pragma unroll
    for (int d0 = 0; d0 < 2; ++d0)
#pragma unroll
        for (int ks = 0; ks < 4; ++ks) {
            const s16x4 lo = vtr(vb + d0 * 4096 + ks * 1024), h4 = vtr(vb + d0 * 4096 + ks * 1024 + 512);
            const bf16x8 vf = (bf16x8){lo[0], lo[1], lo[2], lo[3], h4[0], h4[1], h4[2], h4[3]};
            o[d0] = __builtin_amdgcn_mfma_f32_32x32x16_bf16(__builtin_bit_cast(bf16x8, pw[ks]), vf, o[d0], 0, 0, 0);
        }
}

__device__ __forceinline__ void attn_unit(int b, int h, int qb, const bf16* Q, const bf16* K, const bf16* V, bf16* O, LAS3 unsigned char* lds) {
    const int tid = ltid(), lane = tid & 63, r32 = lane & 31, hi = lane >> 5; const int wid = __builtin_amdgcn_readfirstlane(tid >> 6);
    const size_t rowbase = (size_t)b * SEQ; const int q0 = qb * 256;
    const int myq = q0 + wid * 32 + r32;
    const bf16* Qw = Q + (rowbase + myq) * PITCH + h * HD;
    bf16x8 qr[4];
#pragma unroll
    for (int d0 = 0; d0 < 4; ++d0) qr[d0] = *(const bf16x8*)(Qw + d0 * 16 + hi * 8);
    const bf16* ksrc = K + (rowbase + lane) * PITCH + h * HD + wid * 8;
    const bf16* vsrc = V + (rowbase + 16 * (wid & 3) + (lane >> 2)) * PITCH + h * HD + (wid >> 2) * 32 + (lane & 3) * 8;
    const int stoff = wid * 1024 + lane * 16;
    const int NT = 4 * qb + 4;
    u32x4 kreg = *(const u32x4*)(ksrc + (size_t)(NT - 1) * 64 * PITCH), vreg = *(const u32x4*)(vsrc + (size_t)(NT - 1) * 64 * PITCH);
    *(LAS3 u32x4*)(lds + stoff) = kreg; *(LAS3 u32x4*)(lds + 16384 + stoff) = vreg;
    __syncthreads();
    f32x16 o[2]; o[0] = f32x16{}; o[1] = f32x16{};
    float carry = 1.f; int buf = 0;
    const int tmin = q0 + wid * 32, tmax = tmin + 31;
    LAS3 unsigned* flags = (LAS3 unsigned*)(lds + 32768);
    bool alive = true; int it = 0;
    for (int j = NT - 1; j >= 0; --j, ++it) {
        if (j > 0) { kreg = *(const u32x4*)(ksrc + (size_t)(j - 1) * 64 * PITCH); vreg = *(const u32x4*)(vsrc + (size_t)(j - 1) * 64 * PITCH); }
        if (alive && 64 * j < tmax) {
            const int lim = myq - 64 * j - 4 * hi;
            if (64 * j + 63 >= tmin) tile<true>(o, carry, qr, lds + buf * 8192, lds + 16384 + buf * 8192, lim, r32, hi, lane);
            else tile<false>(o, carry, qr, lds + buf * 8192, lds + 16384 + buf * 8192, lim, r32, hi, lane);
            alive = __builtin_amdgcn_ballot_w64(carry != 0.f) != 0ull;
        }
        if (lane == 0) flags[(it & 1) * 8 + wid] = alive ? 1u : 0u;
        if (j > 0) { *(LAS3 u32x4*)(lds + (buf ^ 1) * 8192 + stoff) = kreg; *(LAS3 u32x4*)(lds + 16384 + (buf ^ 1) * 8192 + stoff) = vreg; }
        __syncthreads();
        buf ^= 1;
        const u32x4 f0 = *(LAS3 const u32x4*)(flags + (it & 1) * 8), f1 = *(LAS3 const u32x4*)(flags + (it & 1) * 8 + 4);
        if (((f0.x | f0.y) | (f0.z | f0.w) | (f1.x | f1.y) | (f1.z | f1.w)) == 0u) break;
    }
    __syncthreads();
    bf16* Ow = O + (rowbase + q0 + wid * 32) * PITCH + h * HD + r32;
#pragma unroll
    for (int r = 0; r < 16; ++r) { const int orow = crow(r, 0) + 4 * hi;
#pragma unroll
        for (int d0 = 0; d0 < 2; ++d0) Ow[(size_t)orow * PITCH + d0 * 32] = (bf16)(cvtpk(o[d0][r], 0.f) & 0xffffu); }
}
}

constexpr int NWAVES = 8;
constexpr int BATCH = 8, SEQ = 2048, D = 1024, DEPTH = 2, FF = 2816, NIN = 5120;
constexpr int M = BATCH * SEQ;
constexpr int N_PHASES = 9 * DEPTH + 1;
#ifndef MK_PER_PHASE
#define MK_PER_PHASE 0
#endif
constexpr size_t KiB = 1024, MiB = 1u << 20;
constexpr size_t WS_CTL = 0, CTL_ZERO_BYTES = 64 * KiB;
constexpr size_t WS_SSQ = 1 * MiB;
constexpr size_t WS_W13A = 2048 * KiB, WS_W2A = 13312 * KiB, WS_WIN = 18944 * KiB, WS_WC = 29184 * KiB, WS_WA = 30208 * KiB, WS_WO = 31232 * KiB, WS_W13B = 33280 * KiB, WS_W2B = 44544 * KiB;
constexpr size_t WS_XB = 49 * MiB;
constexpr size_t WS_ACT = 81 * MiB;
constexpr size_t WS_CB = 81 * MiB, WS_U = 97 * MiB, WS_Q = 113 * MiB, WS_K = 129 * MiB, WS_V = 145 * MiB, WS_G = 161 * MiB, WS_MG = 129 * MiB, WS_YA = 225 * MiB, WS_END = 241 * MiB;
static_assert(WS_SSQ == pg8::EWS_SSQ && WS_XB == pg8::EWS_XB && WS_ACT == pg8::EWS_ACT && WS_CB == pg8::EWS_CB && WS_U == pg8::EWS_U && WS_Q == pg8::EWS_Q && WS_K == pg8::EWS_K && WS_V == pg8::EWS_V && WS_G == pg8::EWS_G && WS_MG == pg8::EWS_MG, "d_ws map shared with the epilogue");
static_assert(WS_W2B + (size_t)D * FF * 2 <= WS_XB && WS_ACT + (size_t)M * FF * 2 <= 256 * MiB && WS_G + (size_t)M * 2048 * 2 <= WS_YA && WS_END <= 256 * MiB, "d_ws map");
constexpr int CW_BAR = 4096;
constexpr int RING_BYTES = 131072, LDSCTL_OFF = RING_BYTES, MISC_OFF = LDSCTL_OFF + 320, LDS_BYTES = 147456;

__device__ __forceinline__ float wave_sum(float v) {
#pragma unroll
    for (int o = 1; o < 64; o <<= 1) v += __shfl_xor(v, o);
    return v;
}
__device__ __forceinline__ int maprow(int mode, int n) {
    if (mode == 1) { if (n < FF) return 256 * (n / 128) + (n % 128); const int j = n - FF; return 256 * (j / 128) + 128 + (j % 128); }
    if (mode == 2) { if (n < 512 || n >= 1536) return n; const int j = (n - 512) & 511, second = (n >= 1024) ? 128 : 0; return 512 + 256 * (j / 128) + second + (j % 128); }
    return n;
}
__device__ __forceinline__ void transpose_item(const float* W, int K, int N, bf16* WT, const float* gain, int mode, int item, int lane) {
    const int nblk = N / 64, kb = item / nblk, nb = item % nblk, k0 = 64 * kb, n0 = 64 * nb;
    const int r4 = lane >> 4, c4 = (lane & 15) * 4;
    f32x4 v[16];
#pragma unroll
    for (int i = 0; i < 16; ++i) v[i] = *(const GAS f32x4*)(W + (size_t)(k0 + 16 * r4 + i) * N + n0 + c4);
    if (gain) {
#pragma unroll
        for (int i = 0; i < 16; ++i) v[i] = v[i] * gain[k0 + 16 * r4 + i]; }
    const int nd0 = maprow(mode, n0);
#pragma unroll
    for (int e = 0; e < 4; ++e)
#pragma unroll
        for (int h2 = 0; h2 < 2; ++h2) { v4u o; o.x = pk2(v[8 * h2][e], v[8 * h2 + 1][e]); o.y = pk2(v[8 * h2 + 2][e], v[8 * h2 + 3][e]); o.z = pk2(v[8 * h2 + 4][e], v[8 * h2 + 5][e]); o.w = pk2(v[8 * h2 + 6][e], v[8 * h2 + 7][e]);
            *(GAS v4u*)(WT + (size_t)(nd0 + c4 + e) * K + k0 + 16 * r4 + 8 * h2) = o; }
}

struct Args { const float* in[15]; float* out; unsigned char* ws; int ph_lo, ph_hi, coop, pad; };

__global__ void __launch_bounds__(NWAVES * 64, 2) fwd_kernel(Args args_) {
    extern __shared__ __attribute__((aligned(16))) unsigned char lds[];
    {   LAS unsigned char* L0 = (LAS unsigned char*)lds;
        for (int u = threadIdx.x; u < (LDS_BYTES - LDSCTL_OFF) / 4; u += NWAVES * 64) ((LAS unsigned*)(L0 + LDSCTL_OFF))[u] = 0u;
        __syncthreads();
        if (args_.ph_hi - args_.ph_lo > 1) (void)xcd_barrier_post((unsigned*)(args_.ws + WS_CTL) + CW_BAR, (volatile LAS unsigned*)(L0 + MISC_OFF) + 8); }
    const int lo = args_.ph_lo, hi = args_.ph_hi;
    for (int ph = lo; ph < hi; ++ph) {
#if defined(PROBE_S0)
        const int reps = (ph != N_PHASES - 1 && (ph % 9 == PROBE_S0 || ph % 9 == PROBE_S1)) ? 2 : 1;
#else
        const int reps = 1;
#endif
        for (int rep = 0; rep < reps; ++rep) {
        const __attribute__((address_space(4))) Args* ap = (const __attribute__((address_space(4))) Args*)__builtin_amdgcn_kernarg_segment_ptr();
        asm volatile("" : "+s"(ap));
        const __attribute__((address_space(4))) Args& args = *ap;
        LAS unsigned char* L = (LAS unsigned char*)lds;
        const int tid = ltid(), lane = tid & 63, wave = __builtin_amdgcn_readfirstlane(tid >> 6);
        const int G = gridDim.x, bid = blockIdx.x;
        const int vcu = (G % 8 == 0) ? (bid % 8) * (G / 8) + bid / 8 : bid;
        unsigned char* ws = args.ws;
        const int gw = vcu * NWAVES + wave, NGW = G * NWAVES;
        const int l = ph / 9, s = ph % 9;
        if (ph == N_PHASES - 1) {
            const float* gfin = args.in[14]; float* const out = args.out;
            for (int m = gw; m < M; m += NGW) { GAS f32x4* xr = (GAS f32x4*)(out + (size_t)m * D) + lane; f32x4 v[4]; float sq = 0.f;
#pragma unroll
                for (int j = 0; j < 4; ++j) { v[j] = xr[64 * j]; sq += (v[j].x * v[j].x + v[j].y * v[j].y) + (v[j].z * v[j].z + v[j].w * v[j].w); }
                const float rs = 1.0f / sqrtf(wave_sum(sq) * (1.0f / D) + 1e-6f);
#pragma unroll
                for (int j = 0; j < 4; ++j) { const f32x4 gg = *((const f32x4*)gfin + 64 * j + lane); xr[64 * j] = v[j] * rs * gg; } }
        } else if (s == 0) {
            const float* w13a = args.in[2] + (size_t)l * D * 2 * FF; const float* w2a = args.in[3] + (size_t)l * FF * D; const float* win = args.in[5] + (size_t)l * D * NIN;
            const float* wc = args.in[8] + (size_t)l * 512 * D; const float* wa = args.in[9] + (size_t)l * 512 * D; const float* wo = args.in[10] + (size_t)l * D * D;
            const float* w13b = args.in[12] + (size_t)l * D * 2 * FF; const float* w2b = args.in[13] + (size_t)l * FF * D;
            const float* g1 = args.in[1] + l * D; const float* gm = args.in[4] + l * D; const float* g2 = args.in[11] + l * D;
            constexpr int I13 = (D / 64) * (2 * FF / 64), I2 = (FF / 64) * (D / 64), IIN = (D / 64) * (NIN / 64), ICO = (512 / 64) * (D / 64), IO = (D / 64) * (D / 64);
            constexpr int NITEMS = 2 * I13 + 2 * I2 + IIN + 2 * ICO + IO;
            for (int it = gw; it < NITEMS; it += NGW) {
                int r = it;
                if (r < I13) { transpose_item(w13a, D, 2 * FF, (bf16*)(ws + WS_W13A), g1, 1, r, lane); continue; } r -= I13;
                if (r < I13) { transpose_item(w13b, D, 2 * FF, (bf16*)(ws + WS_W13B), g2, 1, r, lane); continue; } r -= I13;
                if (r < IIN) { transpose_item(win, D, NIN, (bf16*)(ws + WS_WIN), gm, 2, r, lane); continue; } r -= IIN;
                if (r < I2) { transpose_item(w2a, FF, D, (bf16*)(ws + WS_W2A), nullptr, 0, r, lane); continue; } r -= I2;
                if (r < I2) { transpose_item(w2b, FF, D, (bf16*)(ws + WS_W2B), nullptr, 0, r, lane); continue; } r -= I2;
                if (r < IO) { transpose_item(wo, D, D, (bf16*)(ws + WS_WO), nullptr, 0, r, lane); continue; } r -= IO;
                if (r < ICO) { transpose_item(wc, 512, D, (bf16*)(ws + WS_WC), nullptr, 0, r, lane); continue; } r -= ICO;
                transpose_item(wa, 512, D, (bf16*)(ws + WS_WA), nullptr, 0, r, lane);
            }
            if (l == 0) {
                const float* x = args.in[0]; bf16* const XB = (bf16*)(ws + WS_XB); float* const ssq = (float*)(ws + WS_SSQ);
                for (int m = 2 * gw; m < M; m += 2 * NGW) { const GAS f32x4* xr = (const GAS f32x4*)(x + (size_t)m * D) + lane; f32x4 v[8];
#pragma unroll
                    for (int j = 0; j < 8; ++j) v[j] = xr[64 * j];
#pragma unroll
                    for (int h2 = 0; h2 < 2; ++h2) { float sq = 0.f;
#pragma unroll
                        for (int j = 0; j < 4; ++j) { const f32x4 w = v[4 * h2 + j]; sq += (w.x * w.x + w.y * w.y) + (w.z * w.z + w.w * w.w); }
                        sq = wave_sum(sq);
                        GAS unsigned long long* o8 = (GAS unsigned long long*)(XB + (size_t)(m + h2) * D) + lane;
#pragma unroll
                        for (int j = 0; j < 4; ++j) { const f32x4 w = v[4 * h2 + j]; o8[64 * j] = (unsigned long long)pk2(w.x, w.y) | ((unsigned long long)pk2(w.z, w.w) << 32); }
                        if (lane < 16) ssq[(size_t)(m + h2) * 16 + lane] = lane == 0 ? sq : 0.f; } }
            }
        } else if (s == 4) {
            const float* cw = args.in[7] + (size_t)l * 3 * 512;
            bf16* const CB = (bf16*)(ws + WS_CB); bf16* const U = (bf16*)(ws + WS_U); bf16* const Qb = (bf16*)(ws + WS_Q); bf16* const Kb = (bf16*)(ws + WS_K); bf16* const Vb = (bf16*)(ws + WS_V); bf16* const YA = (bf16*)(ws + WS_YA);
            if (rep == 0) for (int i = bid * (NWAVES * 64) + tid; i < M * 64; i += G * NWAVES * 64) { const int row = i >> 6, c0 = (i & 63) * 8, t = row & (SEQ - 1);
                const pg8::u32x4e zero4 = {0u, 0u, 0u, 0u};
                const pg8::u32x4e cbv = *(const pg8::u32x4e*)(CB + (size_t)row * 512 + c0), u2 = *(const pg8::u32x4e*)(U + (size_t)row * 512 + c0);
                const pg8::u32x4e u1 = t >= 1 ? *(const pg8::u32x4e*)(U + (size_t)(row - 1) * 512 + c0) : zero4, u0 = t >= 2 ? *(const pg8::u32x4e*)(U + (size_t)(row - 2) * 512 + c0) : zero4;
                f32x4 cb0, cb1, a0, a1, b0, b1, c0v, c1v; pg8::unpack8(cbv, cb0, cb1); pg8::unpack8(u0, a0, a1); pg8::unpack8(u1, b0, b1); pg8::unpack8(u2, c0v, c1v);
                const f32x4 w00 = *(const f32x4*)(cw + c0), w01 = *(const f32x4*)(cw + c0 + 4), w10 = *(const f32x4*)(cw + 512 + c0), w11 = *(const f32x4*)(cw + 512 + c0 + 4), w20 = *(const f32x4*)(cw + 1024 + c0), w21 = *(const f32x4*)(cw + 1024 + c0 + 4);
                const f32x4 y0 = cb0 * (w00 * a0 + w10 * b0 + w20 * c0v), y1 = cb1 * (w01 * a1 + w11 * b1 + w21 * c1v);
                *(pg8::u32x4e*)(CB + (size_t)row * 512 + c0) = pg8::pack8(y0, y1); }
            __syncthreads();
            for (int p = vcu; p < 256; p += G) { const int bh = p >> 2, sI = p & 3;
                sba::attn_unit(bh >> 3, bh & 7, 7 - sI, Qb, Kb, Vb, YA, L);
                sba::attn_unit(bh >> 3, bh & 7, sI, Qb, Kb, Vb, YA, L); }
        } else {
            const int ncall = (s == 5) ? 2 : 1;
            for (int c = 0; c < ncall; ++c) {
                pg8::Gemm g{}; pg8::EpiAll E{};
                E.ws = ws; E.outf = nullptr; E.base = nullptr; E.alpha = 0.5f; E.bgate = args.in[6] + (size_t)l * 2048;
                g.M = M;
                if (s == 1)      { g.A = (const bf16*)(ws + WS_XB);  g.Bt = (const bf16*)(ws + WS_W13A); g.N = 2 * FF; g.K = D;  E.mode = pg8::EP_SWIGLU; }
                else if (s == 2) { g.A = (const bf16*)(ws + WS_ACT); g.Bt = (const bf16*)(ws + WS_W2A);  g.N = D;      g.K = FF; E.mode = pg8::EP_RESID; if (l == 0) E.base = args.in[0]; }
                else if (s == 3) { g.A = (const bf16*)(ws + WS_XB);  g.Bt = (const bf16*)(ws + WS_WIN);  g.N = NIN;    g.K = D;  E.mode = pg8::EP_WIN; }
                else if (s == 5) { if (c == 0) { g.A = (const bf16*)(ws + WS_YA); g.Bt = (const bf16*)(ws + WS_WA); E.mode = pg8::EP_MERGE1; } else { g.A = (const bf16*)(ws + WS_CB); g.Bt = (const bf16*)(ws + WS_WC); E.mode = pg8::EP_MERGE2; } g.N = D; g.K = 512; }
                else if (s == 6) { g.A = (const bf16*)(ws + WS_MG);  g.Bt = (const bf16*)(ws + WS_WO);   g.N = D;      g.K = D;  E.mode = pg8::EP_RESID; E.alpha = 1.0f; }
                else if (s == 7) { g.A = (const bf16*)(ws + WS_XB);  g.Bt = (const bf16*)(ws + WS_W13B); g.N = 2 * FF; g.K = D;  E.mode = pg8::EP_SWIGLU; }
                else             { g.A = (const bf16*)(ws + WS_ACT); g.Bt = (const bf16*)(ws + WS_W2B);  g.N = D;      g.K = FF; E.mode = pg8::EP_RESID; if (l == DEPTH - 1) E.outf = args.out; }
                pg8::StaticOrder S; S.init(M, g.N, G, bid);
                pg8::gemm_phase<pg8::EpiAll, pg8::StaticOrder, true, true>(L, g, S, E);
            }
        }
        }
        if (ph + 1 < hi) {
            if (args_.coop == 2) { __threadfence(); cg::this_grid().sync(); }
            else { XcdBarrier bar; bar.bar = (unsigned*)(args_.ws + WS_CTL) + CW_BAR; bar.x = xb_xcc_id(); bar.st = (volatile LAS unsigned*)((LAS unsigned char*)lds + MISC_OFF) + 8; xcd_barrier(bar); }
        }
    }
}

extern "C" void kernel_launch(void* const* d_in, const int* in_sizes, int n_in, void* d_out, int out_size, void* d_ws, size_t ws_size, hipStream_t stream) {
    static int grid = 0;
    if (grid == 0) {
        if (n_in != 15 || in_sizes[0] != M * D || out_size != M * D || ws_size < WS_END) { fprintf(stderr, "kernel_launch: unexpected shapes (n_in %d, in0 %d, out %d, ws %zu); nothing launched\n", n_in, n_in > 0 ? in_sizes[0] : -1, out_size, ws_size); grid = -1; return; }
        int dev = 0, cus = 0, per_cu = 0;
        if (hipGetDevice(&dev) != hipSuccess || hipDeviceGetAttribute(&cus, hipDeviceAttributeMultiprocessorCount, dev) != hipSuccess) { grid = -1; return; }
        if (hipFuncSetAttribute((const void*)fwd_kernel, hipFuncAttributeMaxDynamicSharedMemorySize, LDS_BYTES) != hipSuccess) { fprintf(stderr, "kernel_launch: hipFuncSetAttribute failed\n"); grid = -1; return; }
        if (hipOccupancyMaxActiveBlocksPerMultiprocessor(&per_cu, (const void*)fwd_kernel, NWAVES * 64, LDS_BYTES) != hipSuccess || per_cu < 1) { fprintf(stderr, "kernel_launch: occupancy query says %d blocks per CU; nothing launched\n", per_cu); (void)hipGetLastError(); grid = -1; return; }
        grid = cus < 256 ? cus : 256;
    }
    if (grid < 0) return;
    if (hipMemsetAsync((char*)d_ws + WS_CTL, 0, CTL_ZERO_BYTES, stream) != hipSuccess) { fprintf(stderr, "kernel_launch: hipMemsetAsync failed\n"); return; }
    Args a{};
    for (int i = 0; i < 15; ++i) a.in[i] = (const float*)d_in[i];
    a.out = (float*)d_out; a.ws = (unsigned char*)d_ws;
#if MK_PER_PHASE
    for (int ph = 0; ph < N_PHASES; ++ph) { a.ph_lo = ph; a.ph_hi = ph + 1; a.coop = 0;
        hipLaunchKernelGGL(fwd_kernel, dim3(grid), dim3(NWAVES * 64), LDS_BYTES, stream, a); }
#else
    a.ph_lo = 0; a.ph_hi = N_PHASES; a.coop = 1;
    void* kargs[] = {&a};
    const hipError_t e = hipLaunchCooperativeKernel((const void*)fwd_kernel, dim3(grid), dim3(NWAVES * 64), kargs, LDS_BYTES, stream);
    if (e != hipSuccess) fprintf(stderr, "kernel_launch: cooperative launch failed: %s (grid %d)\n", hipGetErrorString(e), grid);
#endif
}
```
